# Optimizing an MI355X kernel written in HIP

```python
import math
import jax, jax.numpy as jnp
from jax import lax
import numpy as np

D_MODEL = 2048
BATCH = 8
SEQ = 2048
DEPTH = 2

N_HEADS = 16
N_KV_HEADS = 4
HEAD_DIM = D_MODEL // N_HEADS
WINDOW = 128
BLOCK = 128
GMLP_GROUPS = 16
GMLP_GROUP_DIM = D_MODEL // GMLP_GROUPS
GMLP_WIDTH = GMLP_GROUPS * GMLP_GROUP_DIM
CHUNK = 128
D_FF_DENSE = 5632
N_EXPERTS = 8
TOP_K = 2
D_FF_EXPERT = 7168
EPS = 1e-6
NEG_INF = -1e30

kernel_name = 'hybrid_swa_gmlp_moe_encoder'


def rmsnorm(x, g):
    xf = x.astype(jnp.float32)
    y = xf * lax.rsqrt(jnp.mean(xf * xf, axis=-1, keepdims=True) + EPS)
    return (y * g.astype(jnp.float32)).astype(x.dtype)


def alibi_slopes(n):
    return jnp.exp2(-8.0 * jnp.arange(1, n + 1, dtype=jnp.float32) / n)


def windowed_gqa_attention(h, w_qkv, q_norm, k_norm, sink, w_o):
    B, S, _ = h.shape
    nb = S // BLOCK
    G = N_HEADS // N_KV_HEADS
    qkv = h @ w_qkv
    q, k, v = jnp.split(qkv, [N_HEADS * HEAD_DIM, (N_HEADS + N_KV_HEADS) * HEAD_DIM], axis=-1)
    q = rmsnorm(q.reshape(B, S, N_HEADS, HEAD_DIM), q_norm)
    k = rmsnorm(k.reshape(B, S, N_KV_HEADS, HEAD_DIM), k_norm)
    v = v.reshape(B, S, N_KV_HEADS, HEAD_DIM)
    q = q.reshape(B, nb, BLOCK, N_KV_HEADS, G, HEAD_DIM)

    def band(t):
        tp = jnp.pad(t, ((0, 0), (BLOCK, BLOCK), (0, 0), (0, 0)))
        tb = tp.reshape(B, nb + 2, BLOCK, N_KV_HEADS, HEAD_DIM)
        return jnp.concatenate([tb[:, :-2], tb[:, 1:-1], tb[:, 2:]], axis=2)

    kb, vb = band(k), band(v)
    scores = jnp.einsum('bnqkgd,bnskd->bkgnqs', q, kb,
                        preferred_element_type=jnp.float32) * (HEAD_DIM ** -0.5)
    qi = jnp.arange(BLOCK)[:, None]
    sj = jnp.arange(3 * BLOCK)[None, :]
    dist = jnp.abs(qi - sj + BLOCK)
    key_pos = jnp.arange(nb)[:, None, None] * BLOCK - BLOCK + sj[None]
    valid = (dist[None] <= WINDOW) & (key_pos >= 0) & (key_pos < S)
    slopes = alibi_slopes(N_HEADS).reshape(N_KV_HEADS, G)
    bias = -slopes[:, :, None, None] * dist.astype(jnp.float32)
    scores = jnp.where(valid, scores + bias[:, :, None], NEG_INF)
    s_logit = sink.astype(jnp.float32).reshape(N_KV_HEADS, G)[None, :, :, None, None, None]
    m = jnp.maximum(jnp.max(scores, axis=-1, keepdims=True), s_logit)
    p = jnp.exp(scores - m)
    probs = p / (jnp.sum(p, axis=-1, keepdims=True) + jnp.exp(s_logit - m))
    out = jnp.einsum('bkgnqs,bnskd->bnqkgd', probs.astype(vb.dtype), vb)
    return out.reshape(B, S, N_HEADS * HEAD_DIM) @ w_o


def chunked_spatial_gating(h, w_in, v_norm, w_s, b_s, w_out):
    B, S, _ = h.shape
    nc = S // CHUNK
    z = jax.nn.gelu(h @ w_in)
    u, v = jnp.split(z, 2, axis=-1)
    v = rmsnorm(v, v_norm).reshape(B, nc, CHUNK, GMLP_GROUPS, GMLP_GROUP_DIM)
    v = jnp.einsum('gts,bcsgd->bctgd', w_s, v) + b_s.T[:, :, None]
    y = u * v.reshape(B, S, GMLP_WIDTH)
    return y @ w_out


def dense_swiglu(h, w_gate_up, w_down):
    g, u = jnp.split(h @ w_gate_up, 2, axis=-1)
    return (jax.nn.silu(g) * u) @ w_down


def moe_swiglu(h, w_router, we_gate, we_up, we_down):
    B, S, D = h.shape
    t = h.reshape(B * S, D)
    logits = (t @ w_router).astype(jnp.float32)
    top_vals, top_idx = lax.top_k(logits, TOP_K)
    top_w = jax.nn.softmax(top_vals, axis=-1)
    gates = jnp.sum(jax.nn.one_hot(top_idx, N_EXPERTS, dtype=jnp.float32) * top_w[..., None], axis=1)
    gates = gates.astype(t.dtype)
    y = jnp.zeros_like(t)
    for e in range(N_EXPERTS):
        he = jax.nn.silu(t @ we_gate[e]) * (t @ we_up[e])
        y = y + gates[:, e:e + 1] * (he @ we_down[e])
    return y.reshape(B, S, D)


def setup_inputs(seed: int = 0) -> dict:
    key = jax.random.key(seed)
    ks = jax.random.split(key, 24)
    f32 = jnp.float32

    def nrm(k, shape, scale):
        return jax.random.normal(k, shape, f32) * scale

    def gain(k, n):
        return 1.0 + 0.02 * jax.random.normal(k, (n,), f32)

    qkv_out = (N_HEADS + 2 * N_KV_HEADS) * HEAD_DIM
    return {
        'x': jax.random.normal(ks[0], (BATCH, SEQ, D_MODEL), f32),
        'l0_mix_norm': gain(ks[1], D_MODEL),
        'l0_w_qkv': nrm(ks[2], (D_MODEL, qkv_out), D_MODEL ** -0.5),
        'l0_q_norm': gain(ks[3], HEAD_DIM),
        'l0_k_norm': gain(ks[4], HEAD_DIM),
        'l0_sink': nrm(ks[5], (N_HEADS,), 1.0),
        'l0_w_o': nrm(ks[6], (N_HEADS * HEAD_DIM, D_MODEL), (N_HEADS * HEAD_DIM) ** -0.5),
        'l0_ffn_norm': gain(ks[7], D_MODEL),
        'l0_w_gate_up': nrm(ks[8], (D_MODEL, 2 * D_FF_DENSE), D_MODEL ** -0.5),
        'l0_w_down': nrm(ks[9], (D_FF_DENSE, D_MODEL), D_FF_DENSE ** -0.5),
        'l1_mix_norm': gain(ks[10], D_MODEL),
        'l1_w_in': nrm(ks[11], (D_MODEL, 2 * GMLP_WIDTH), D_MODEL ** -0.5),
        'l1_v_norm': gain(ks[12], GMLP_WIDTH),
        'l1_w_s': nrm(ks[13], (GMLP_GROUPS, CHUNK, CHUNK), CHUNK ** -0.5),
        'l1_b_s': 1.0 + 0.02 * jax.random.normal(ks[14], (GMLP_GROUPS, CHUNK), f32),
        'l1_w_out': nrm(ks[15], (GMLP_WIDTH, D_MODEL), GMLP_WIDTH ** -0.5),
        'l1_ffn_norm': gain(ks[16], D_MODEL),
        'l1_w_router': nrm(ks[17], (D_MODEL, N_EXPERTS), D_MODEL ** -0.5),
        'l1_we_gate': nrm(ks[18], (N_EXPERTS, D_MODEL, D_FF_EXPERT), D_MODEL ** -0.5),
        'l1_we_up': nrm(ks[19], (N_EXPERTS, D_MODEL, D_FF_EXPERT), D_MODEL ** -0.5),
        'l1_we_down': nrm(ks[20], (N_EXPERTS, D_FF_EXPERT, D_MODEL), D_FF_EXPERT ** -0.5),
    }


def reference(x,
              l0_mix_norm, l0_w_qkv, l0_q_norm, l0_k_norm, l0_sink, l0_w_o,
              l0_ffn_norm, l0_w_gate_up, l0_w_down,
              l1_mix_norm, l1_w_in, l1_v_norm, l1_w_s, l1_b_s, l1_w_out,
              l1_ffn_norm, l1_w_router, l1_we_gate, l1_we_up, l1_we_down):
    layers = [
        dict(mix_norm=l0_mix_norm, mix=(l0_w_qkv, l0_q_norm, l0_k_norm, l0_sink, l0_w_o),
             ffn_norm=l0_ffn_norm, ffn=(l0_w_gate_up, l0_w_down)),
        dict(mix_norm=l1_mix_norm, mix=(l1_w_in, l1_v_norm, l1_w_s, l1_b_s, l1_w_out),
             ffn_norm=l1_ffn_norm, ffn=(l1_w_router, l1_we_gate, l1_we_up, l1_we_down)),
    ]
    for i in range(DEPTH):
        p = layers[i]
        h = rmsnorm(x, p['mix_norm'])
        if i % 2 == 0:
            x = x + windowed_gqa_attention(h, *p['mix'])
        else:
            x = x + chunked_spatial_gating(h, *p['mix'])
        h = rmsnorm(x, p['ffn_norm'])
        if i % 2 == 0:
            x = x + dense_swiglu(h, *p['ffn'])
        else:
            x = x + moe_swiglu(h, *p['ffn'])
    return x
```

```cpp
#include <hip/hip_runtime.h>
#include <cstdio>
#include <cstdint>

#ifndef USE_SIMPLE_GEMM
#define USE_SIMPLE_GEMM 0
#endif
#ifndef MK_N_LAUNCHES
#define MK_N_LAUNCHES 1
#endif
#ifndef WGM13
#define WGM13 4
#endif
#ifndef WGM14
#define WGM14 4
#endif
#ifndef PG8_ALIGN_F8
#define PG8_ALIGN_F8 true
#endif
#ifndef PG8_ALIGN_BF
#define PG8_ALIGN_BF true
#endif

namespace pg8 {
#define PG8_LAS __attribute__((address_space(3)))
typedef unsigned short bf16_t;
typedef short bf16x8 __attribute__((ext_vector_type(8)));
typedef float f32x4 __attribute__((ext_vector_type(4)));
typedef unsigned u32x4 __attribute__((ext_vector_type(4)));
typedef unsigned u32x2 __attribute__((ext_vector_type(2)));
constexpr int BM = 256, BK = 64, HALF = 128, HTB = HALF * BK * 2  , STAGE_BYTES = 8 * HTB, NXCD = 8, WGM = 4;

__host__ __device__ __forceinline__ int lds_byte(int r, int c) { const int st = (r >> 4) * 2 + (c >> 5), rr = r & 15, cc = c & 31, ob = rr * 64 + cc * 2; return st * 1024 + (ob ^ (((ob >> 9) & 1) << 5)); }
__host__ __device__ __forceinline__ void stage_rc(int b, int& R, int& C) { const int st = b / 1024, sb = b % 1024, swz = sb ^ (((sb >> 9) & 1) << 5); R = (st >> 1) * 16 + swz / 64; C = (st & 1) * 32 + (swz % 64) / 2; }
__host__ __device__ __forceinline__ int perm32(int rho) { const int n = rho >> 4, i = rho & 15; return 8 * (i >> 2) + 4 * n + (i & 3); }

struct Unit { int pm, pn, pb, ko, aux; };
struct Gemm { const bf16_t* A; const bf16_t* Bt; int M, N, K, Kl; };
__host__ __device__ __forceinline__ void map_unit(int L, int nM, int nN, int nwg, int& pm, int& pn, int WGM_ = WGM) {
    int wgid = L; { const int q = nwg / NXCD, r = nwg % NXCD, xcd = wgid % NXCD, off = wgid / NXCD; wgid = (xcd < r ? xcd * (q + 1) : r * (q + 1) + (xcd - r) * q) + off; }
    const int nig = WGM_ * nN, gid = wgid / nig, fm = gid * WGM_, gsz = (nM - fm) < WGM_ ? (nM - fm) : WGM_;
    pm = fm + ((wgid % nig) % gsz); pn = (wgid % nig) / gsz; }

struct StaticOrder {
    int nM, nN, nwg, G, c, i0, i1;
    __host__ __device__ void init(int M, int N, int G_, int c_) { nM = M / BM; nN = N / BM; nwg = nM * nN; G = G_; c = c_; i0 = 0; i1 = 0x7fffffff; }
    __host__ __device__ bool next(int i, Unit& u) const {
        if (i >= i1 - i0) return false;
        const long L = (long)(i + i0) * G + c; if (L >= nwg) return false;
        int wgid = (int)L; { const int q = nwg / NXCD, r = nwg % NXCD, xcd = wgid % NXCD, off = wgid / NXCD; wgid = (xcd < r ? xcd * (q + 1) : r * (q + 1) + (xcd - r) * q) + off; }
        const int nig = WGM * nN, gid = wgid / nig, fm = gid * WGM, gsz = (nM - fm) < WGM ? (nM - fm) : WGM;
        u.pm = fm + ((wgid % nig) % gsz); u.pn = (wgid % nig) / gsz; u.pb = u.pn; u.ko = 0; u.aux = 0; return true;
    }
    __device__ __forceinline__ void a_ready(const Unit&) const {}
    __device__ __forceinline__ void done(const Unit&) const {}
};
struct GroupedOrder {
    int nM, nN, nwg, G, c, lim, wgm; const PG8_LAS int* texp;
    __device__ void init(int nM_, int N, int G_, int c_, const PG8_LAS int* t, int wgm_) { nM = nM_; nN = N / BM; nwg = nM * nN; G = G_; c = c_; texp = t; lim = nwg; wgm = wgm_; }
    __device__ bool next(int i, Unit& u) const {
        const long L = (long)i * G + c; if (L >= lim) return false;
        map_unit((int)L, nM, nN, nwg, u.pm, u.pn, wgm); u.pb = __builtin_amdgcn_readfirstlane(texp[u.pm]) * nN + u.pn; u.ko = 0; u.aux = 0; return true;
    }
    __device__ __forceinline__ void a_ready(const Unit&) const {}
    __device__ __forceinline__ void done(const Unit&) const {}
};
struct TailOrder {
    int nM, nN, nwg, c, L0, nsub, s, klen, wgm; const PG8_LAS int* texp;
    __device__ bool next(int i, Unit& u) const {
        if (i != 0 || c >= nsub) return false;
        const int q = c / s, ch = c - q * s;
        map_unit(L0 + q, nM, nN, nwg, u.pm, u.pn, wgm); u.pb = __builtin_amdgcn_readfirstlane(texp[u.pm]) * nN + u.pn; u.ko = ch * klen; u.aux = c; return true;
    }
    __device__ __forceinline__ void a_ready(const Unit&) const {}
    __device__ __forceinline__ void done(const Unit&) const {}
};

__device__ __forceinline__ unsigned cvt_pk_bf16(float lo, float hi) { unsigned r; asm volatile("v_cvt_pk_bf16_f32 %0, %1, %2" : "=v"(r) : "v"(lo), "v"(hi)); return r; }
__device__ __forceinline__ float sigmoid_f(float x) { return __builtin_amdgcn_rcpf(1.0f + __builtin_amdgcn_exp2f(-1.4426950408889634f * x)); }
__device__ __forceinline__ float silu_f(float x) { return x * sigmoid_f(x); }
__device__ __forceinline__ float gelu_tanh_f(float x) { const float in = 0.7978845608028654f * (x + 0.044715f * x * x * x); return x * sigmoid_f(2.0f * in); }

struct EpiRowScale {
    static constexpr bool PERM = true, AFTER_DRAIN = false;
    bf16_t* O; int ldc; const float* rs; float cs;
    __device__ __forceinline__ void operator()(const f32x4 (&acc)[2][2][4][2], const Unit& u, int wr, int wc, int fr, int fq) const {
        const int row0 = u.pm * BM + wr * 64 + fr, col0 = u.pn * BM + wc * 32 + 8 * fq;
#pragma unroll
        for (int ai = 0; ai < 2; ++ai)
#pragma unroll
            for (int m = 0; m < 4; ++m) { const int row = row0 + ai * HALF + m * 16; const float s = rs[row] * cs; bf16_t* rowp = O + (size_t)row * ldc + col0;
#pragma unroll
                for (int bj = 0; bj < 2; ++bj) { const f32x4 v0 = acc[ai][bj][m][0] * s, v1 = acc[ai][bj][m][1] * s;
                    u32x4 w; w.x = cvt_pk_bf16(v0[0], v0[1]); w.y = cvt_pk_bf16(v0[2], v0[3]); w.z = cvt_pk_bf16(v1[0], v1[1]); w.w = cvt_pk_bf16(v1[2], v1[3]);
                    *(u32x4*)(rowp + bj * HALF) = w; } }
    }
};
struct EpiPartial {
    static constexpr bool PERM = false, AFTER_DRAIN = false;
    float* P;
    __device__ __forceinline__ void operator()(const f32x4 (&acc)[2][2][4][2], const Unit& u, int wr, int wc, int fr, int fq) const {
        float* base = P + (size_t)u.aux * 65536 + (size_t)(wr * 64 + fr) * 256 + wc * 32 + 4 * fq;
#pragma unroll
        for (int ai = 0; ai < 2; ++ai)
#pragma unroll
            for (int m = 0; m < 4; ++m)
#pragma unroll
                for (int bj = 0; bj < 2; ++bj)
#pragma unroll
                    for (int n = 0; n < 2; ++n) *(f32x4*)(base + (size_t)(ai * HALF + m * 16) * 256 + bj * HALF + n * 16) = acc[ai][bj][m][n];
    }
};
template <int OUT8  > struct EpiSwiGLU {
    static constexpr bool PERM = true, AFTER_DRAIN = false;
    bf16_t* O; int ldc; const float* rs; float cs;
    __device__ __forceinline__ void operator()(const f32x4 (&acc)[2][2][4][2], const Unit& u, int wr, int wc, int fr, int fq) const {
        const int row0 = u.pm * BM + wr * 64 + fr, col0 = u.pn * HALF + wc * 32 + 8 * fq;
#pragma unroll
        for (int ai = 0; ai < 2; ++ai) {
            float hh[4][8];
#pragma unroll
            for (int m = 0; m < 4; ++m) { const int row = row0 + ai * HALF + m * 16; const float s = rs ? rs[row] : cs;
                const float ns = -1.4426950408889634f * s, c2 = s * s * (OUT8 == 1 ? 8.0f : (OUT8 == 2 ? 2.5f : 1.0f));
                float h[8];
#pragma unroll
                for (int n = 0; n < 2; ++n) { const f32x4 g4 = acc[ai][0][m][n], u4 = acc[ai][1][m][n]; const f32x4 t4 = g4 * ns; f32x4 e4;
                    e4[0] = __builtin_amdgcn_exp2f(t4[0]); e4[1] = __builtin_amdgcn_exp2f(t4[1]); e4[2] = __builtin_amdgcn_exp2f(t4[2]); e4[3] = __builtin_amdgcn_exp2f(t4[3]);
                    const f32x4 d4 = e4 + 1.0f; f32x4 r4;
                    r4[0] = __builtin_amdgcn_rcpf(d4[0]); r4[1] = __builtin_amdgcn_rcpf(d4[1]); r4[2] = __builtin_amdgcn_rcpf(d4[2]); r4[3] = __builtin_amdgcn_rcpf(d4[3]);
                    const f32x4 h4 = (g4 * u4) * (r4 * c2);
#pragma unroll
                    for (int j = 0; j < 4; ++j) h[n * 4 + j] = OUT8 == 1 ? __builtin_amdgcn_fmed3f(h4[j], -448.0f, 448.0f) : (OUT8 == 2 ? __builtin_amdgcn_fmed3f(h4[j], -28.0f, 28.0f) : h4[j]); }
                if (OUT8 == 1) {
                    int lo_ = __builtin_amdgcn_cvt_pk_fp8_f32(h[0], h[1], 0, false); lo_ = __builtin_amdgcn_cvt_pk_fp8_f32(h[2], h[3], lo_, true);
                    int hi_ = __builtin_amdgcn_cvt_pk_fp8_f32(h[4], h[5], 0, false); hi_ = __builtin_amdgcn_cvt_pk_fp8_f32(h[6], h[7], hi_, true);
                    u32x2 w; w.x = (unsigned)lo_; w.y = (unsigned)hi_; *(u32x2*)((unsigned char*)O + (size_t)row * ldc + col0) = w; }
                else if (OUT8 == 2) {
#pragma unroll
                    for (int e = 0; e < 8; ++e) hh[m][e] = h[e]; }
                else { u32x4 w; w.x = cvt_pk_bf16(h[0], h[1]); w.y = cvt_pk_bf16(h[2], h[3]); w.z = cvt_pk_bf16(h[4], h[5]); w.w = cvt_pk_bf16(h[6], h[7]);
                    *(u32x4*)(O + (size_t)row * ldc + col0) = w; } }
            if (OUT8 == 2) {
                typedef float v16f_ __attribute__((ext_vector_type(16))); typedef unsigned v6u_ __attribute__((ext_vector_type(6)));
                v16f_ a, b;
#pragma unroll
                for (int e = 0; e < 8; ++e) { unsigned x0 = __builtin_bit_cast(unsigned, hh[0][e]), x1 = __builtin_bit_cast(unsigned, hh[1][e]), x2 = __builtin_bit_cast(unsigned, hh[2][e]), x3 = __builtin_bit_cast(unsigned, hh[3][e]);
                    const auto r02 = __builtin_amdgcn_permlane32_swap(x0, x2, false, false); x0 = r02[0]; x2 = r02[1];
                    const auto r13 = __builtin_amdgcn_permlane32_swap(x1, x3, false, false); x1 = r13[0]; x3 = r13[1];
                    const auto r01 = __builtin_amdgcn_permlane16_swap(x0, x1, false, false); x0 = r01[0]; x1 = r01[1];
                    const auto r23 = __builtin_amdgcn_permlane16_swap(x2, x3, false, false); x2 = r23[0]; x3 = r23[1];
                    a[e] = __builtin_bit_cast(float, x0); a[8 + e] = __builtin_bit_cast(float, x1); b[e] = __builtin_bit_cast(float, x2); b[8 + e] = __builtin_bit_cast(float, x3); }
                const v6u_ r = __builtin_amdgcn_cvt_scalef32_2xpk16_bf6_f32(a, b, 1.0f);
                unsigned char* q = (unsigned char*)O + (size_t)(row0 + ai * HALF + 16 * fq) * ldc + u.pn * HALF + wc * 16;
                u32x4 o0, o1; o0.x = r[0]; o0.y = r[1]; o0.z = r[2]; o0.w = r[3]; o1.x = r[4]; o1.y = r[5]; o1.z = 0u; o1.w = 0u;
                *(u32x4*)q = o0; *(u32x4*)(q + 64) = o1; }
        }
    }
};
struct EpiGelu {
    static constexpr bool PERM = true, AFTER_DRAIN = false;
    bf16_t* O; int ldc; const float* rs; float* part; int pn_stat;
    __device__ __forceinline__ void operator()(const f32x4 (&acc)[2][2][4][2], const Unit& u, int wr, int wc, int fr, int fq) const {
        const int row0 = u.pm * BM + wr * 64 + fr, col0 = u.pn * BM + wc * 32 + 8 * fq;
        const bool st = u.pn >= pn_stat;
        const float A = -0.044715f * 1.5957691216057308f * 1.4426950408889634f, B = -1.5957691216057308f * 1.4426950408889634f;
#pragma unroll
        for (int ai = 0; ai < 2; ++ai)
#pragma unroll
            for (int m = 0; m < 4; ++m) { const int row = row0 + ai * HALF + m * 16; const float s = rs[row]; bf16_t* rowp = O + (size_t)row * ldc + col0; f32x4 sq = (f32x4){0.f, 0.f, 0.f, 0.f};
#pragma unroll
                for (int bj = 0; bj < 2; ++bj) { f32x4 z[2];
#pragma unroll
                    for (int n = 0; n < 2; ++n) { const f32x4 v4 = acc[ai][bj][m][n] * s; const f32x4 a4 = v4 * ((v4 * v4) * A + B); f32x4 e4;
                        e4[0] = __builtin_amdgcn_exp2f(a4[0]); e4[1] = __builtin_amdgcn_exp2f(a4[1]); e4[2] = __builtin_amdgcn_exp2f(a4[2]); e4[3] = __builtin_amdgcn_exp2f(a4[3]);
                        const f32x4 d4 = e4 + 1.0f; f32x4 r4;
                        r4[0] = __builtin_amdgcn_rcpf(d4[0]); r4[1] = __builtin_amdgcn_rcpf(d4[1]); r4[2] = __builtin_amdgcn_rcpf(d4[2]); r4[3] = __builtin_amdgcn_rcpf(d4[3]);
                        z[n] = v4 * r4; sq += z[n] * z[n]; }
                    u32x4 w; w.x = cvt_pk_bf16(z[0][0], z[0][1]); w.y = cvt_pk_bf16(z[0][2], z[0][3]); w.z = cvt_pk_bf16(z[1][0], z[1][1]); w.w = cvt_pk_bf16(z[1][2], z[1][3]);
                    *(u32x4*)(rowp + bj * HALF) = w; }
                float ssq = (sq[0] + sq[1]) + (sq[2] + sq[3]);
                ssq += __shfl_xor(ssq, 16); ssq += __shfl_xor(ssq, 32);
                if (st && fq == 0) part[(size_t)row * 32 + (u.pn - pn_stat) * 4 + wc] = ssq; }
    }
};
template <bool BASE_F32, bool OUT_F32, bool OUT_BF16, bool STATS>
struct EpiRes {
    static constexpr bool PERM = true, AFTER_DRAIN = false;
    const float* basef; const bf16_t* baseb; float* outf; bf16_t* outb; float* part; int ldc;
    __device__ __forceinline__ void operator()(const f32x4 (&acc)[2][2][4][2], const Unit& u, int wr, int wc, int fr, int fq) const {
        const int row0 = u.pm * BM + wr * 64 + fr, col0 = u.pn * BM + wc * 32 + 8 * fq;
#pragma unroll
        for (int ai = 0; ai < 2; ++ai)
#pragma unroll
            for (int m = 0; m < 4; ++m) { const int row = row0 + ai * HALF + m * 16; const size_t off = (size_t)row * ldc + col0; float ssq = 0.f;
#pragma unroll
                for (int bj = 0; bj < 2; ++bj) { const size_t o2 = off + bj * HALF; f32x4 b0, b1;
                    if (BASE_F32) { b0 = *(const f32x4*)(basef + o2); b1 = *(const f32x4*)(basef + o2 + 4); }
                    else { const u32x4 w = *(const u32x4*)(baseb + o2);
                        b0 = (f32x4){__uint_as_float(w.x << 16), __uint_as_float(w.x & 0xffff0000u), __uint_as_float(w.y << 16), __uint_as_float(w.y & 0xffff0000u)};
                        b1 = (f32x4){__uint_as_float(w.z << 16), __uint_as_float(w.z & 0xffff0000u), __uint_as_float(w.w << 16), __uint_as_float(w.w & 0xffff0000u)}; }
                    const f32x4 o0 = b0 + acc[ai][bj][m][0], o1 = b1 + acc[ai][bj][m][1];
                    if (OUT_F32) { *(f32x4*)(outf + o2) = o0; *(f32x4*)(outf + o2 + 4) = o1; }
                    if (OUT_BF16) { u32x4 w; w.x = cvt_pk_bf16(o0[0], o0[1]); w.y = cvt_pk_bf16(o0[2], o0[3]); w.z = cvt_pk_bf16(o1[0], o1[1]); w.w = cvt_pk_bf16(o1[2], o1[3]); *(u32x4*)(outb + o2) = w; }
                    if (STATS) ssq += ((o0[0] * o0[0] + o0[1] * o0[1]) + (o0[2] * o0[2] + o0[3] * o0[3])) + ((o1[0] * o1[0] + o1[1] * o1[1]) + (o1[2] * o1[2] + o1[3] * o1[3])); }
                if (STATS) { ssq += __shfl_xor(ssq, 16); ssq += __shfl_xor(ssq, 32); if (fq == 0) part[(size_t)row * 32 + u.pn * 4 + wc] = ssq; }
                asm volatile("" ::: "memory"); }
    }
};

typedef int v8i_t __attribute__((ext_vector_type(8)));
typedef int v4i_t __attribute__((ext_vector_type(4)));
typedef int v6i_t __attribute__((ext_vector_type(6)));
typedef int v2i_t __attribute__((ext_vector_type(2)));
__device__ __forceinline__ f32x4 mma_f8(bf16x8 b0, bf16x8 b1, bf16x8 a0, bf16x8 a1, f32x4 c) {
    const v4i_t x0 = __builtin_bit_cast(v4i_t, b0), x1 = __builtin_bit_cast(v4i_t, b1), y0 = __builtin_bit_cast(v4i_t, a0), y1 = __builtin_bit_cast(v4i_t, a1);
    const v8i_t x = __builtin_shufflevector(x0, x1, 0, 1, 2, 3, 4, 5, 6, 7), y = __builtin_shufflevector(y0, y1, 0, 1, 2, 3, 4, 5, 6, 7);
    return __builtin_amdgcn_mfma_scale_f32_16x16x128_f8f6f4(x, y, c, 0, 0, 0, 0x7F7F7F7F, 0, 0x7F7F7F7F);
}

template <class Epi, class Sched, bool ALIGN_EPI = false, bool SP2 = false, int F8 = 0>
__device__ __forceinline__ void gemm_phase(PG8_LAS unsigned char* lds, const Gemm g, const Sched& S, const Epi& E) {
    const int tid = threadIdx.x, wid = __builtin_amdgcn_readfirstlane(tid >> 6), lane = tid & 63, wr = wid >> 2, wc = wid & 3, fr = lane & 15, fq = lane >> 4;
    const int K = g.K, nt = g.Kl / BK;
    unsigned voffA[2], voffB[2];
#pragma unroll
    for (int i = 0; i < 2; ++i) { int R, C; stage_rc(tid * 16 + i * 8192, R, C); const int Rb = Epi::PERM ? ((R & ~31) + perm32(R & 31)) : R;
        voffA[i] = (unsigned)(R * K + C) * 2u; voffB[i] = (unsigned)(Rb * K + C) * 2u; }
    const size_t kstep = (size_t)(BK * 2);
    const size_t hstep = (size_t)HALF * K * 2;
    const size_t tstep = 2 * hstep;
    const unsigned ldsw = (unsigned)wid * 1024u;
    const int aoff = lds_byte(wr * 64 + fr, fq * 8), boff = lds_byte(wc * 32 + fr, fq * 8);
#define PG8_SA(b, h) (((b) * 2 + (h)) * HTB)
#define PG8_SB(b, h) ((4 + (b) * 2 + (h)) * HTB)
#define PG8_STAGE(bufoff, gbase, voff) do { _Pragma("unroll") for (int _i = 0; _i < 2; ++_i) \
        __builtin_amdgcn_global_load_lds((const unsigned*)((const char*)(gbase) + (voff)[_i]), (PG8_LAS unsigned*)(lds + (bufoff) + ldsw + _i * 8192), 16, 0, 0); } while (0)
#define PG8_LDA(dst, b, h) do { if constexpr (F8 >= 2) { _Pragma("unroll") for (int m = 0; m < 4; ++m) { const v4i_t l0_ = *(const PG8_LAS v4i_t*)(lds + PG8_SA(b, h) + aoff + m * 2048); const v2i_t l1_ = *(const volatile PG8_LAS v2i_t*)(lds + PG8_SA(b, h) + aoff + m * 2048 + 1024); dst##6[m] = (v6i_t){l0_.x, l0_.y, l0_.z, l0_.w, l1_.x, l1_.y}; } } \
        else if constexpr (F8 == 1) { _Pragma("unroll") for (int m = 0; m < 4; ++m) { const v4i_t l0_ = *(const PG8_LAS v4i_t*)(lds + PG8_SA(b, h) + aoff + m * 2048), l1_ = *(const PG8_LAS v4i_t*)(lds + PG8_SA(b, h) + aoff + m * 2048 + 1024); dst##8[m] = __builtin_shufflevector(l0_, l1_, 0, 1, 2, 3, 4, 5, 6, 7); } } \
        else { _Pragma("unroll") for (int m = 0; m < 4; ++m) _Pragma("unroll") for (int k = 0; k < 2; ++k) dst[m][k] = *(const PG8_LAS bf16x8*)(lds + PG8_SA(b, h) + aoff + m * 2048 + k * 1024); } } while (0)
#define PG8_LDB(dst, b, h) do { if constexpr (F8 >= 2) { _Pragma("unroll") for (int n = 0; n < 2; ++n) { const v4i_t l0_ = *(const PG8_LAS v4i_t*)(lds + PG8_SB(b, h) + boff + n * 2048); const v2i_t l1_ = *(const volatile PG8_LAS v2i_t*)(lds + PG8_SB(b, h) + boff + n * 2048 + 1024); dst##6[n] = (v6i_t){l0_.x, l0_.y, l0_.z, l0_.w, l1_.x, l1_.y}; } } \
        else if constexpr (F8 == 1) { _Pragma("unroll") for (int n = 0; n < 2; ++n) { const v4i_t l0_ = *(const PG8_LAS v4i_t*)(lds + PG8_SB(b, h) + boff + n * 2048), l1_ = *(const PG8_LAS v4i_t*)(lds + PG8_SB(b, h) + boff + n * 2048 + 1024); dst##8[n] = __builtin_shufflevector(l0_, l1_, 0, 1, 2, 3, 4, 5, 6, 7); } } \
        else { _Pragma("unroll") for (int n = 0; n < 2; ++n) _Pragma("unroll") for (int k = 0; k < 2; ++k) dst[n][k] = *(const PG8_LAS bf16x8*)(lds + PG8_SB(b, h) + boff + n * 2048 + k * 1024); } } while (0)
#define PG8_MMA(ai, bj, At, Bt) do { __builtin_amdgcn_s_setprio(1); _Pragma("unroll") for (int m = 0; m < 4; ++m) _Pragma("unroll") for (int n = 0; n < 2; ++n) { \
        if constexpr (F8 == 3) asm volatile("v_mfma_scale_f32_16x16x128_f8f6f4 %0, %1, %2, %0, %3, %3 op_sel_hi:[0,0,0] cbsz:2 blgp:3" : "+v"(acc[ai][bj][m][n]) : "v"(Bt##6[n]), "v"(At##6[m]), "v"(sc8_)); \
        else if constexpr (F8 == 2) asm volatile("v_mfma_scale_f32_16x16x128_f8f6f4 %0, %1, %2, %0, %3, %3 op_sel_hi:[0,0,0] cbsz:2 blgp:2" : "+v"(acc[ai][bj][m][n]) : "v"(Bt##6[n]), "v"(At##6[m]), "v"(sc8_)); \
        else if constexpr (F8 == 1) asm volatile("v_mfma_scale_f32_16x16x128_f8f6f4 %0, %1, %2, %0, %3, %3 op_sel_hi:[0,0,0]" : "+v"(acc[ai][bj][m][n]) : "v"(Bt##8[n]), "v"(At##8[m]), "v"(sc8_)); \
        else { _Pragma("unroll") for (int k = 0; k < 2; ++k) acc[ai][bj][m][n] = __builtin_amdgcn_mfma_f32_16x16x32_bf16(Bt[n][k], At[m][k], acc[ai][bj][m][n], 0, 0, 0); } } __builtin_amdgcn_s_setprio(0); } while (0)
#define PG8_WAIT_V(n) asm volatile("s_waitcnt vmcnt(" #n ")" ::: "memory")
#define PG8_WAIT_L(n) asm volatile("s_waitcnt lgkmcnt(" #n ")" ::: "memory")
#define PG8_BAR __builtin_amdgcn_s_barrier()
#define PG8_SCHED __builtin_amdgcn_sched_barrier(0)
    Unit cur, nxt; int ui = 0;
    if (!S.next(0, cur)) return;
    f32x4 acc[2][2][4][2];
#pragma unroll
    for (int a = 0; a < 2; ++a)
#pragma unroll
        for (int b = 0; b < 2; ++b)
#pragma unroll
            for (int m = 0; m < 4; ++m)
#pragma unroll
                for (int n = 0; n < 2; ++n) acc[a][b][m][n] = (f32x4){0.f, 0.f, 0.f, 0.f};
    bf16x8 At[4][2], B0[2][2], B1[2][2]; v8i_t At8[4], B08[2], B18[2]; v6i_t At6[4], B06[2], B16[2]; const int sc8_ = 0x7F7F7F7F;
    const char* cA = (const char*)g.A + (size_t)cur.pm * tstep + (size_t)cur.ko * 2; const char* cB = (const char*)g.Bt + (size_t)cur.pb * tstep + (size_t)cur.ko * 2;
    S.a_ready(cur);
    if constexpr (SP2) {
        PG8_STAGE(PG8_SB(0, 0), cB, voffB); PG8_STAGE(PG8_SB(0, 1), cB + hstep, voffB); PG8_STAGE(PG8_SA(0, 0), cA, voffA); PG8_STAGE(PG8_SA(0, 1), cA + hstep, voffA);
        if (wr == 1) PG8_BAR;
        PG8_WAIT_V(2); PG8_BAR;
        PG8_STAGE(PG8_SB(1, 0), cB + kstep, voffB); PG8_STAGE(PG8_SA(1, 0), cA + kstep, voffA); PG8_STAGE(PG8_SB(1, 1), cB + hstep + kstep, voffB);
        PG8_WAIT_V(6); PG8_BAR;
    } else {
        PG8_STAGE(PG8_SB(0, 0), cB, voffB); PG8_STAGE(PG8_SA(0, 0), cA, voffA); PG8_STAGE(PG8_SB(0, 1), cB + hstep, voffB); PG8_STAGE(PG8_SA(0, 1), cA + hstep, voffA);
        if (wr == 1) PG8_BAR;
        PG8_WAIT_V(4); PG8_BAR;
        PG8_STAGE(PG8_SB(1, 0), cB + kstep, voffB); PG8_STAGE(PG8_SA(1, 0), cA + kstep, voffA); PG8_STAGE(PG8_SB(1, 1), cB + hstep + kstep, voffB);
        PG8_WAIT_V(6); PG8_BAR;
    }
    for (;;) {
        const bool has_next = S.next(ui + 1, nxt);
        const char* nA = has_next ? (const char*)g.A + (size_t)nxt.pm * tstep + (size_t)nxt.ko * 2 : cA; const char* nB = has_next ? (const char*)g.Bt + (size_t)nxt.pb * tstep + (size_t)nxt.ko * 2 : cB;
        for (int t = 0; t < nt; t += 2) {
            const bool last = (t == nt - 2);
            const char* a1 = cA + (size_t)(t + 1) * kstep;
            const char* a2 = last ? nA : cA + (size_t)(t + 2) * kstep; const char* b2 = last ? nB : cB + (size_t)(t + 2) * kstep;
            const char* a3 = a2 + kstep; const char* b3 = b2 + kstep;
            if (last && has_next) S.a_ready(nxt);
            if constexpr (SP2) {
            PG8_LDB(B0, 0, 0); PG8_LDB(B1, 0, 1); PG8_SCHED; PG8_LDA(At, 0, 0); PG8_STAGE(PG8_SA(1, 1), a1 + hstep, voffA);
            PG8_WAIT_V(8); PG8_WAIT_L(0); PG8_BAR; PG8_MMA(0, 0, At, B0); PG8_MMA(0, 1, At, B1); PG8_BAR; PG8_SCHED;
            PG8_LDA(At, 0, 1); PG8_STAGE(PG8_SB(0, 0), b2, voffB); PG8_STAGE(PG8_SB(0, 1), b2 + hstep, voffB); PG8_STAGE(PG8_SA(0, 0), a2, voffA);
            PG8_WAIT_V(8); PG8_WAIT_L(0); PG8_BAR; PG8_MMA(1, 0, At, B0); PG8_MMA(1, 1, At, B1); PG8_BAR; PG8_SCHED;
            PG8_LDB(B0, 1, 0); PG8_LDB(B1, 1, 1); PG8_SCHED; PG8_LDA(At, 1, 0); PG8_STAGE(PG8_SA(0, 1), a2 + hstep, voffA);
            PG8_WAIT_V(8); PG8_WAIT_L(0); PG8_BAR; PG8_MMA(0, 0, At, B0); PG8_MMA(0, 1, At, B1); PG8_BAR; PG8_SCHED;
            PG8_LDA(At, 1, 1); PG8_STAGE(PG8_SB(1, 0), b3, voffB); PG8_STAGE(PG8_SB(1, 1), b3 + hstep, voffB); PG8_STAGE(PG8_SA(1, 0), a3, voffA);
            PG8_WAIT_V(8); PG8_WAIT_L(0); PG8_BAR; PG8_MMA(1, 0, At, B0); PG8_MMA(1, 1, At, B1); PG8_BAR; PG8_SCHED;
            } else {
            PG8_LDB(B0, 0, 0); PG8_SCHED; PG8_LDA(At, 0, 0); PG8_STAGE(PG8_SA(1, 1), a1 + hstep, voffA);
            PG8_WAIT_L(8); PG8_BAR; PG8_WAIT_L(0); PG8_MMA(0, 0, At, B0); PG8_BAR; PG8_SCHED;
            PG8_LDB(B1, 0, 1); PG8_STAGE(PG8_SB(0, 0), b2, voffB);
            PG8_BAR; PG8_WAIT_L(0); PG8_MMA(0, 1, At, B1); PG8_BAR;
            PG8_LDA(At, 0, 1); PG8_STAGE(PG8_SA(0, 0), a2, voffA);
            PG8_BAR; PG8_WAIT_L(0); PG8_MMA(1, 0, At, B0); PG8_BAR; PG8_SCHED;
            PG8_STAGE(PG8_SB(0, 1), b2 + hstep, voffB);
            PG8_WAIT_V(6); PG8_BAR; PG8_MMA(1, 1, At, B1); PG8_BAR;
            PG8_LDB(B0, 1, 0); PG8_SCHED; PG8_LDA(At, 1, 0); PG8_STAGE(PG8_SA(0, 1), a2 + hstep, voffA);
            PG8_WAIT_L(8); PG8_BAR; PG8_WAIT_L(0); PG8_MMA(0, 0, At, B0); PG8_BAR; PG8_SCHED;
            PG8_LDB(B1, 1, 1); PG8_STAGE(PG8_SB(1, 0), b3, voffB);
            PG8_BAR; PG8_WAIT_L(0); PG8_MMA(0, 1, At, B1); PG8_BAR;
            PG8_LDA(At, 1, 1); PG8_STAGE(PG8_SA(1, 0), a3, voffA);
            PG8_BAR; PG8_WAIT_L(0); PG8_MMA(1, 0, At, B0); PG8_BAR; PG8_SCHED;
            PG8_STAGE(PG8_SB(1, 1), b3 + hstep, voffB);
            PG8_WAIT_V(6); PG8_BAR; PG8_MMA(1, 1, At, B1); PG8_BAR;
            }
        }
        if constexpr (ALIGN_EPI) { if (wr == 0) PG8_BAR; }
        if constexpr (F8) asm volatile("s_nop 15\n\ts_nop 15" ::: "memory");
        if constexpr (!Epi::AFTER_DRAIN) { E(acc, cur, wr, wc, fr, fq); S.done(cur); }
        if (!has_next) break;
#pragma unroll
        for (int a = 0; a < 2; ++a)
#pragma unroll
            for (int b = 0; b < 2; ++b)
#pragma unroll
                for (int m = 0; m < 4; ++m)
#pragma unroll
                    for (int n = 0; n < 2; ++n) acc[a][b][m][n] = (f32x4){0.f, 0.f, 0.f, 0.f};
        cur = nxt; cA = nA; cB = nB; ++ui;
        if constexpr (ALIGN_EPI) { if (wr == 1) PG8_BAR; }
    }
    PG8_WAIT_V(0);
    if constexpr (!ALIGN_EPI) { if (wr == 0) PG8_BAR; }
    PG8_BAR;
    if constexpr (Epi::AFTER_DRAIN) { E.fused(acc, cur, wr, wc, fr, fq, lds, wid, lane); S.done(cur); }
#undef PG8_SA
#undef PG8_SB
#undef PG8_STAGE
#undef PG8_LDA
#undef PG8_LDB
#undef PG8_MMA
#undef PG8_WAIT_V
#undef PG8_WAIT_L
#undef PG8_BAR
#undef PG8_SCHED
}

template <class Epi, class Sched>
__device__ __forceinline__ void gemm_phase_simple(const Gemm g, const Sched& S, const Epi& E) {
    const int tid = threadIdx.x, wid = __builtin_amdgcn_readfirstlane(tid >> 6), lane = tid & 63, wr = wid >> 2, wc = wid & 3, fr = lane & 15, fq = lane >> 4;
    const int K = g.K; Unit u;
    for (int i = 0; S.next(i, u); ++i) {
        f32x4 acc[2][2][4][2];
#pragma unroll
        for (int a = 0; a < 2; ++a)
#pragma unroll
            for (int b = 0; b < 2; ++b)
#pragma unroll
                for (int m = 0; m < 4; ++m)
#pragma unroll
                    for (int n = 0; n < 2; ++n) acc[a][b][m][n] = (f32x4){0.f, 0.f, 0.f, 0.f};
        const bf16_t* Ab = g.A + (size_t)u.pm * BM * K + u.ko; const bf16_t* Bb = g.Bt + (size_t)u.pb * BM * K + u.ko;
        for (int k0 = 0; k0 < g.Kl; k0 += 32) {
            bf16x8 a[2][4], b[2][2];
#pragma unroll
            for (int ai = 0; ai < 2; ++ai)
#pragma unroll
                for (int m = 0; m < 4; ++m) a[ai][m] = *(const bf16x8*)(Ab + (size_t)(ai * HALF + wr * 64 + m * 16 + fr) * K + k0 + fq * 8);
#pragma unroll
            for (int bj = 0; bj < 2; ++bj)
#pragma unroll
                for (int n = 0; n < 2; ++n) { const int rl = 16 * n + fr, rr = Epi::PERM ? perm32(rl) : rl; b[bj][n] = *(const bf16x8*)(Bb + (size_t)(bj * HALF + wc * 32 + rr) * K + k0 + fq * 8); }
#pragma unroll
            for (int ai = 0; ai < 2; ++ai)
#pragma unroll
                for (int bj = 0; bj < 2; ++bj)
#pragma unroll
                    for (int m = 0; m < 4; ++m)
#pragma unroll
                        for (int n = 0; n < 2; ++n) acc[ai][bj][m][n] = __builtin_amdgcn_mfma_f32_16x16x32_bf16(b[bj][n], a[ai][m], acc[ai][bj][m][n], 0, 0, 0);
        }
        E(acc, u, wr, wc, fr, fq);
    }
}
}

constexpr int NWAVES = 8;
constexpr int N_LAUNCHES = MK_N_LAUNCHES;
constexpr int N_PHASES = 17;
constexpr int M = 16384, D = 2048, SEQ = 2048, NQKV = 3072, NH = 16, NKV = 4, HD = 128;
constexpr int FF = 5632, GWD = 2048, NE = 8, FE = 7168;
constexpr int PMAX = 2 * M + NE * 256;
constexpr float EPS = 1e-6f;
constexpr float W8SCALE = 64.0f, A8SCALE = 4.0f, H8SCALE = 8.0f;
constexpr float W6SCALE = 80.0f, A6SCALE = 1.75f, W6SCALE_D = 150.0f, H6SCALE = 2.5f;

constexpr size_t MiB = 1u << 20, KiB = 1u << 10;
constexpr size_t WS_CTL = 0, CTL_ZERO_BYTES = 1 * MiB;
constexpr size_t WS_RSTD0 = 1 * MiB, WS_RSTD1 = WS_RSTD0 + 64 * KiB, WS_RSTD2 = WS_RSTD1 + 64 * KiB, WS_ROWW = WS_RSTD2 + 64 * KiB  , WS_TEXP = WS_ROWW + 192 * KiB;
constexpr size_t WS_ROUTE = 2 * MiB;
constexpr size_t WS_PART = 3 * MiB, WS_PARTV = 5 * MiB;
constexpr size_t WS_WQKV = 8 * MiB, WS_WO = 20 * MiB, WS_WGU = 28 * MiB, WS_WD = 72 * MiB, WS_WIN = 94 * MiB, WS_WOUT = 110 * MiB, WS_WEGU = 118 * MiB, WS_WED = 566 * MiB;
constexpr size_t WS_HB = 790 * MiB;
constexpr size_t WS_R = 854 * MiB;
constexpr size_t WS_QKV = WS_R, WS_AO = WS_R + 96 * MiB;
constexpr size_t WS_HFF = WS_R;
constexpr size_t WS_Z = WS_R, WS_Y = WS_R + 128 * MiB;
constexpr size_t WS_HS = WS_R, WS_HE = WS_R + 136 * MiB;
constexpr size_t WS_PTL = WS_R + 612 * MiB;
constexpr size_t WS_END = WS_PTL + 64 * MiB;
static_assert(WS_WO - WS_WQKV >= (size_t)NQKV * D * 2 && WS_WD - WS_WGU >= (size_t)2 * FF * D * 2 && WS_WIN - WS_WD >= (size_t)FF * D * 2 && WS_WED - WS_WEGU >= (size_t)NE * 2 * FE * D * 2 && WS_HB - WS_WED >= (size_t)NE * FE * D * 2, "weights map");
static_assert(WS_HE - WS_HS >= (size_t)PMAX * D * 2 && WS_END - WS_HE >= (size_t)PMAX * FE * 2 && WS_AO - WS_QKV >= (size_t)M * NQKV * 2 && (size_t)M * FF * 2 <= 612 * MiB && WS_Y - WS_Z >= (size_t)M * 2 * GWD * 2, "activation map");
constexpr int CW_TMO = 0, CW_NMT = 2, CW_BAR = 4096, CW_CNT = 8192;

constexpr int RING_OFF = 0, RING_BYTES = 131072;
constexpr int LDSCTL_OFF = RING_BYTES, MISC_OFF = LDSCTL_OFF + 320;
constexpr int TEXP_OFF = LDSCTL_OFF + 1024;
constexpr int LDS_BYTES = 147456;
static_assert(TEXP_OFF + 4 * 160 <= LDS_BYTES, "LDS map");

#define GAS __attribute__((address_space(1)))
#define LAS __attribute__((address_space(3)))
typedef unsigned short bf16;
typedef unsigned v4u __attribute__((ext_vector_type(4)));
typedef unsigned v2u __attribute__((ext_vector_type(2)));
typedef float f32x4 __attribute__((ext_vector_type(4)));
typedef short bf16x8 __attribute__((ext_vector_type(8)));
typedef GAS unsigned gu32;
#define RLX_AGENT __ATOMIC_RELAXED, __HIP_MEMORY_SCOPE_AGENT
#define LDS_WAIT() asm volatile("s_waitcnt lgkmcnt(0)" ::: "memory")
#define VM_WAIT() asm volatile("s_waitcnt vmcnt(0)" ::: "memory")
__device__ __forceinline__ unsigned f2bf(float f) { unsigned u = __builtin_bit_cast(unsigned, f); return (u + 0x7fffu + ((u >> 16) & 1u)) >> 16; }
__device__ __forceinline__ unsigned pk2(float lo, float hi) { return f2bf(lo) | (f2bf(hi) << 16); }
__device__ __forceinline__ float bf2f(unsigned short b) { return __uint_as_float((unsigned)b << 16); }
__device__ __forceinline__ float bflo(unsigned w) { return __uint_as_float(w << 16); }
__device__ __forceinline__ float bfhi(unsigned w) { return __uint_as_float(w & 0xffff0000u); }

#define XB_TMO      128
#define XB_XCNT(j)  (256  + 64 * (j))
#define XB_XSUB(j)  (1280 + 64 * (j))
#define XB_XGEN(j)  (2304 + 64 * (j))
#define XB_TOP      3328
#define XB_TOPGEN   3392
#define XCD_BAR_WORDS 3456
#define XB_SPIN_CAP (1u << 18)

__device__ __forceinline__ unsigned xb_ld(unsigned* p)              { return __hip_atomic_load(p, __ATOMIC_RELAXED, __HIP_MEMORY_SCOPE_AGENT); }
__device__ __forceinline__ unsigned xb_add(unsigned* p, unsigned v) { return __hip_atomic_fetch_add(p, v, __ATOMIC_RELAXED, __HIP_MEMORY_SCOPE_AGENT); }
__device__ __forceinline__ unsigned xb_xcc_id() { return (unsigned)__builtin_amdgcn_s_getreg((3 << 11) | 20) & 0xFu; }
#define XB_SPIN(cond, bar) do { unsigned _sp = 0; while (cond) { __builtin_amdgcn_s_sleep(1); \
    if ((++_sp & 255u) == 0u) { if (xb_ld(&(bar)[XB_TMO])) break; if (_sp > XB_SPIN_CAP) { atomicAdd(&(bar)[XB_TMO], 1u); break; } } } } while (0)

struct XcdBarrier {
    unsigned* bar; unsigned x;
    volatile LAS unsigned* st;
};

__device__ __forceinline__ XcdBarrier xcd_barrier_post(unsigned* bar, volatile LAS unsigned* st) {
    XcdBarrier b; b.bar = bar; b.x = xb_xcc_id(); b.st = st;
    if (threadIdx.x == 0) (void)xb_add(&bar[XB_XCNT(b.x)], 1u);
    return b;
}
__device__ __forceinline__ void xcd_barrier_complete(unsigned* bar, unsigned x, unsigned& nloc, unsigned& nx) {
    const unsigned G = gridDim.x * gridDim.y * gridDim.z;
    unsigned sum, cnt, mine, sp = 0u;
    for (;;) {
        sum = 0u; cnt = 0u; mine = 0u;
#pragma unroll
        for (unsigned j = 0; j < 16; ++j) { const unsigned c = xb_ld(&bar[XB_XCNT(j)]); sum += c; cnt += (c > 0u) ? 1u : 0u; mine = (j == x) ? c : mine; }
        if (sum == G) break;
        __builtin_amdgcn_s_sleep(1);
        if ((++sp & 255u) == 0u) { if (xb_ld(&bar[XB_TMO])) break; if (sp > XB_SPIN_CAP) { atomicAdd(&bar[XB_TMO], 1u); break; } }
    }
    nloc = mine > 0u ? mine : 1u; nx = cnt > 0u ? cnt : 1u;
}

__device__ __forceinline__ void xcd_barrier(const XcdBarrier& b) {
    asm volatile("s_waitcnt vmcnt(0)" ::: "memory");
    __syncthreads();
    if (threadIdx.x == 0) {
        unsigned* bar = b.bar;
        __builtin_amdgcn_s_waitcnt(0);
        unsigned nloc = b.st[0], nx = b.st[1];
        if (nloc == 0u) { xcd_barrier_complete(bar, b.x, nloc, nx); b.st[0] = nloc; b.st[1] = nx; }
        const unsigned old = xb_add(&bar[XB_XSUB(b.x)], 1u);
        const unsigned gen = old / nloc;
        if (old + 1u == (gen + 1u) * nloc) {
            __builtin_amdgcn_fence(__ATOMIC_RELEASE, "agent");
            asm volatile("s_waitcnt vmcnt(0)" ::: "memory");
            const unsigned og = xb_add(&bar[XB_TOP], 1u);
            const unsigned tg = og / nx;
            if (og + 1u == (tg + 1u) * nx) xb_add(&bar[XB_TOPGEN], 1u);
            else XB_SPIN(xb_ld(&bar[XB_TOPGEN]) == tg, bar);
            __builtin_amdgcn_fence(__ATOMIC_ACQUIRE, "agent");
            xb_add(&bar[XB_XGEN(b.x)], 1u);
            asm volatile("s_waitcnt vmcnt(0)" ::: "memory");
        } else {
            XB_SPIN(xb_ld(&bar[XB_XGEN(b.x)]) == gen, bar);
            __builtin_amdgcn_fence(__ATOMIC_ACQUIRE, "agent");
            asm volatile("s_waitcnt vmcnt(0)" ::: "memory");
        }
    }
    __syncthreads();
}

__device__ __forceinline__ float wave_sum(float v) {
#pragma unroll
    for (int o = 1; o < 64; o <<= 1) v += __shfl_xor(v, o);
    return v;
}

__device__ __forceinline__ unsigned cvt4_fp8(float a, float b, float c, float d) { int r = __builtin_amdgcn_cvt_pk_fp8_f32(a, b, 0, false); r = __builtin_amdgcn_cvt_pk_fp8_f32(c, d, r, true); return (unsigned)r; }
struct MoeDesc { const float* src; unsigned char* dst; int ldw, K, k0, n0, mode; };
constexpr int MOE_IE = 32 * 112;
constexpr int NMOE = 3 * NE * MOE_IE;
__device__ __forceinline__ void moe_desc(int r, const float* wg, const float* wu, const float* wd, unsigned char* dgu, unsigned char* dd, MoeDesc& d) {
    const int sel = (r >= NE * MOE_IE ? 1 : 0) + (r >= 2 * NE * MOE_IE ? 1 : 0);
    const int rr = r - sel * NE * MOE_IE, e = rr / MOE_IE, ri = rr - e * MOE_IE;
    const int kb = (sel == 2) ? ri / 32 : ri / 112, nb = ri - kb * ((sel == 2) ? 32 : 112);
    d.ldw = (sel == 2) ? D : FE; d.K = (sel == 2) ? FE : D; d.mode = (sel == 2) ? 0 : sel + 1; d.k0 = 64 * kb; d.n0 = 64 * nb;
    const float* base = (sel == 0) ? wg : ((sel == 1) ? wu : wd);
    d.src = base + (size_t)e * D * FE + (size_t)d.k0 * d.ldw + d.n0;
    d.dst = (sel == 2) ? dd + (size_t)e * D * FE : dgu + (size_t)e * 2 * FE * D;
}
__device__ __forceinline__ void moe_load(const MoeDesc& d, f32x4 (&v)[16], int lane) {
    const float* p = d.src + (size_t)(16 * (lane & 3)) * d.ldw + (lane >> 2) * 4;
#pragma unroll
    for (int i = 0; i < 16; ++i) v[i] = __builtin_nontemporal_load((const f32x4*)(p + (size_t)i * d.ldw));
}
__device__ __forceinline__ void moe_store(const MoeDesc& d, const f32x4 (&v)[16], int lane) {
    const int kc = lane & 3, nq = lane >> 2;
#pragma unroll
    for (int j = 0; j < 4; ++j) { const int nn = d.n0 + 4 * nq + j; const int drow = (d.mode == 0) ? nn : ((nn >> 7) * 256 + (nn & 127) + (d.mode == 2 ? 128 : 0));
        v4u o;
        o.x = cvt4_fp8(v[0][j] * W8SCALE, v[1][j] * W8SCALE, v[2][j] * W8SCALE, v[3][j] * W8SCALE);     o.y = cvt4_fp8(v[4][j] * W8SCALE, v[5][j] * W8SCALE, v[6][j] * W8SCALE, v[7][j] * W8SCALE);
        o.z = cvt4_fp8(v[8][j] * W8SCALE, v[9][j] * W8SCALE, v[10][j] * W8SCALE, v[11][j] * W8SCALE); o.w = cvt4_fp8(v[12][j] * W8SCALE, v[13][j] * W8SCALE, v[14][j] * W8SCALE, v[15][j] * W8SCALE);
        __builtin_nontemporal_store(o, (GAS v4u*)(d.dst + (size_t)drow * d.K + d.k0 + 16 * kc)); }
}

typedef float f32x2 __attribute__((ext_vector_type(2)));
typedef float v16f_t __attribute__((ext_vector_type(16)));
typedef unsigned v6u_t __attribute__((ext_vector_type(6)));
constexpr int NMOE6 = 3 * NE * MOE_IE;
struct Moe6Desc { const float* src; unsigned char* dst; int ldw, K, k0, n0, mode; float sc; };
__device__ __forceinline__ void moe6_desc(int r, const float* wg, const float* wu, const float* wd, unsigned char* dgu, unsigned char* dd, Moe6Desc& d) {
    const int sel = (r >= NE * MOE_IE ? 1 : 0) + (r >= 2 * NE * MOE_IE ? 1 : 0);
    const int rr = r - sel * NE * MOE_IE, e = rr / MOE_IE, ri = rr - e * MOE_IE;
    const int nbn = (sel == 2) ? 64 : 224, kb = ri / nbn, nb = ri - kb * nbn;
    d.ldw = (sel == 2) ? D : FE; d.K = (sel == 2) ? FE : D; d.mode = (sel == 2) ? 0 : sel + 1; d.k0 = 128 * kb; d.n0 = 32 * nb; d.sc = (sel == 2) ? W6SCALE_D : W6SCALE;
    const float* base = (sel == 0) ? wg : ((sel == 1) ? wu : wd);
    d.src = base + (size_t)e * D * FE + (size_t)d.k0 * d.ldw + d.n0;
    d.dst = (sel == 2) ? dd + (size_t)e * D * FE : dgu + (size_t)e * 2 * FE * D;
}
__device__ __forceinline__ void moe6_load(const Moe6Desc& d, f32x4 (&v)[16], int lane) {
    const float* p = d.src + (size_t)(16 * (lane & 7)) * d.ldw + (lane >> 3) * 4;
#pragma unroll
    for (int i = 0; i < 16; ++i) v[i] = __builtin_nontemporal_load((const f32x4*)(p + (size_t)i * d.ldw));
}
__device__ __forceinline__ float clamp6(float x) { return __builtin_amdgcn_fmed3f(x, -7.5f, 7.5f); }
__device__ __forceinline__ float swap1(float x) { return __int_as_float(__builtin_amdgcn_update_dpp(0, __float_as_int(x), 0xB1  , 0xF, 0xF, true)); }
__device__ __forceinline__ void moe6_store(const Moe6Desc& d, const f32x4 (&v)[16], int lane) {
    const int kc = lane & 7, nq = lane >> 3; const bool odd = lane & 1; const unsigned om = 0u - (unsigned)(lane & 1);
#pragma unroll
    for (int j = 0; j < 2; ++j) { const int nn = d.n0 + 4 * nq + (odd ? 2 : 0) + j; const int drow = (d.mode == 0) ? nn : ((nn >> 7) * 256 + (nn & 127) + (d.mode == 2 ? 128 : 0));
        v16f_t a, b;
#pragma unroll
        for (int i = 0; i < 16; ++i) { const unsigned x0 = __float_as_uint(v[i][j]), x1 = __float_as_uint(v[i][2 + j]);
            const unsigned keep = (x1 & om) | (x0 & ~om), send = (x0 & om) | (x1 & ~om), recv = __float_as_uint(swap1(__uint_as_float(send)));
            a[i] = clamp6(__uint_as_float((recv & om) | (keep & ~om)) * d.sc); b[i] = clamp6(__uint_as_float((keep & om) | (recv & ~om)) * d.sc); }
        const v6u_t r = __builtin_amdgcn_cvt_scalef32_2xpk16_fp6_f32(a, b, 1.0f);
        unsigned char* q = d.dst + (size_t)drow * d.K + d.k0 + 16 * (kc >> 1);
        v4u o0, o1; o0.x = r[0]; o0.y = r[1]; o0.z = r[2]; o0.w = r[3]; o1.x = r[4]; o1.y = r[5]; o1.z = 0u; o1.w = 0u;
        __builtin_nontemporal_store(o0, (GAS v4u*)q); __builtin_nontemporal_store(o1, (GAS v4u*)(q + 64)); }
}

typedef float f32x16 __attribute__((ext_vector_type(16)));
typedef short s16x4 __attribute__((ext_vector_type(4)));
typedef short v4i16_t __attribute__((ext_vector_type(4)));
typedef float f32x2_t __attribute__((ext_vector_type(2)));
typedef __bf16 bf16x2_t __attribute__((ext_vector_type(2)));
__device__ __forceinline__ unsigned cvtpk(float lo, float hi) { f32x2_t v = {lo, hi}; bf16x2_t b = __builtin_convertvector(v, bf16x2_t); return __builtin_bit_cast(unsigned, b); }
__device__ __forceinline__ s16x4 tr_read(const LAS unsigned char* p) { return __builtin_bit_cast(s16x4, __builtin_amdgcn_ds_read_tr16_b64_v4i16((LAS v4i16_t*)p)); }
__device__ __forceinline__ int crow(int i, int h) { return (i & 3) + 8 * (i >> 2) + 4 * h; }
#define MFMA32(a, b, c) __builtin_amdgcn_mfma_f32_32x32x16_bf16((a), (b), (c), 0, 0, 0)
constexpr int AT_STRIDE = 272;
constexpr int AT_VSTRIDE = 320;
constexpr int AT_K = 0, AT_V = 128 * AT_STRIDE, AT_END = AT_V + 128 * AT_VSTRIDE;

struct DenseDesc { const float* src; const float* gain; bf16* dst; int ldw, K, k0, n0, mode, hg; };
constexpr int DN0 = 32 * 48, DN1 = 32 * 32, DN2 = 32 * 88, DN3 = DN2, DN4 = 88 * 32, DN5 = 32 * 64, DN6 = 32 * 32;
constexpr int DB1 = DN0, DB2 = DB1 + DN1, DB3 = DB2 + DN2, DB4 = DB3 + DN3, DB5 = DB4 + DN4, DB6 = DB5 + DN5, NDENSE2 = DB6 + DN6;
struct DensePtrs { const float *wqkv, *wo, *wgu, *wd, *win, *wout, *g0, *g1, *g2; bf16 *dqkv, *dwo, *dgu, *dd, *din, *dout; };
__device__ __forceinline__ void dense_desc(int r, const DensePtrs& P, DenseDesc& d) {
    int ri, nblk; const float* w; const float* g; bf16* dst; int ldw, K = D, mode = 0, hg = 0, coff = 0;
    if (r < DB1)      { ri = r;       nblk = 48; w = P.wqkv; g = P.g0; hg = 1; dst = P.dqkv; ldw = NQKV; }
    else if (r < DB2) { ri = r - DB1; nblk = 32; w = P.wo;   g = P.g0;         dst = P.dwo;  ldw = D; }
    else if (r < DB3) { ri = r - DB2; nblk = 88; w = P.wgu;  g = P.g1; hg = 1; dst = P.dgu;  ldw = 2 * FF; mode = 1; }
    else if (r < DB4) { ri = r - DB3; nblk = 88; w = P.wgu;  g = P.g1; hg = 1; dst = P.dgu;  ldw = 2 * FF; mode = 2; coff = FF; }
    else if (r < DB5) { ri = r - DB4; nblk = 32; w = P.wd;   g = P.g0;         dst = P.dd;   ldw = D; K = FF; }
    else if (r < DB6) { ri = r - DB5; nblk = 64; w = P.win;  g = P.g2; hg = 1; dst = P.din;  ldw = 2 * GWD; }
    else              { ri = r - DB6; nblk = 32; w = P.wout; g = P.g0;         dst = P.dout; ldw = D; }
    const int kb = ri / nblk, nb = ri - kb * nblk;
    d.ldw = ldw; d.K = K; d.mode = mode; d.hg = hg; d.k0 = 64 * kb; d.n0 = 64 * nb;
    d.src = w + (size_t)d.k0 * ldw + coff + d.n0;
    d.gain = g + (hg ? d.k0 : 0);
    d.dst = dst;
}
__device__ __forceinline__ void dense_load(const DenseDesc& d, f32x4 (&v)[16], f32x4 (&gv)[4], int lane) {
    const float* gp = d.gain + 16 * (lane & 3);
#pragma unroll
    for (int q = 0; q < 4; ++q) { const f32x4 gl = *(const f32x4*)(gp + 4 * q); gv[q] = d.hg ? gl : (f32x4){1.f, 1.f, 1.f, 1.f}; }
    const float* p = d.src + (size_t)(16 * (lane & 3)) * d.ldw + (lane >> 2) * 4;
#pragma unroll
    for (int i = 0; i < 16; ++i) v[i] = __builtin_nontemporal_load((const f32x4*)(p + (size_t)i * d.ldw));
}
__device__ __forceinline__ void dense_store(const DenseDesc& d, const f32x4 (&v)[16], const f32x4 (&gv)[4], int lane) {
    const int kc = lane & 3, nq = lane >> 2;
#pragma unroll
    for (int j = 0; j < 4; ++j) { const int nn = d.n0 + 4 * nq + j; const int drow = (d.mode == 0) ? nn : ((nn >> 7) * 256 + (nn & 127) + (d.mode == 2 ? 128 : 0));
        v4u o0, o1;
        o0.x = cvtpk(v[0][j] * gv[0][0], v[1][j] * gv[0][1]);   o0.y = cvtpk(v[2][j] * gv[0][2], v[3][j] * gv[0][3]);   o0.z = cvtpk(v[4][j] * gv[1][0], v[5][j] * gv[1][1]);   o0.w = cvtpk(v[6][j] * gv[1][2], v[7][j] * gv[1][3]);
        o1.x = cvtpk(v[8][j] * gv[2][0], v[9][j] * gv[2][1]);   o1.y = cvtpk(v[10][j] * gv[2][2], v[11][j] * gv[2][3]); o1.z = cvtpk(v[12][j] * gv[3][0], v[13][j] * gv[3][1]); o1.w = cvtpk(v[14][j] * gv[3][2], v[15][j] * gv[3][3]);
        GAS v4u* q = (GAS v4u*)(d.dst + (size_t)drow * d.K + d.k0 + 16 * kc); q[0] = o0; q[1] = o1; }
}

__device__ __forceinline__ void attn_phase(LAS unsigned char* lds, const bf16* QKV, bf16* AO, const float* qn, const float* kn, const float* sink, int bid, int G, int tid) {
    const int lane = tid & 63, wid = __builtin_amdgcn_readfirstlane(tid >> 6), r = lane & 31, h = lane >> 5;
    const int q4 = (lane & 15) >> 2, p4 = lane & 3, blk = (lane >> 4) & 1;
    const int ch = tid & 15, srow = tid >> 4;
    const float L2E = 1.4426950408889634f, SC = 0.08838834764831845f * L2E;
    for (int u = bid; u < 1024; u += G) {
        const int qhalf = u & 1, kvh = (u >> 1) & 3, nb = (u >> 3) & 15, b = u >> 7;
        const int hq = kvh * 4 + (wid >> 1);
        const int tw = nb * 128 + qhalf * 64 + (wid & 1) * 32, t = tw + r;
        const int jb0 = nb > 0 ? nb - 1 : 0, jb1 = nb < 15 ? nb + 1 : 15;
        v4u kreg[4], vreg[4];
#define AT_ISSUE(jb_) do { _Pragma("unroll") for (int i = 0; i < 4; ++i) { const bf16* kp_ = QKV + (size_t)(b * SEQ + (jb_) * 128 + srow + 32 * i) * NQKV + NH * HD + kvh * HD + ch * 8; \
            kreg[i] = *(const v4u*)kp_; vreg[i] = *(const v4u*)(kp_ + NKV * HD); } } while (0)
        AT_ISSUE(jb0);
        bf16x8 qf[8];
        {
            const bf16* qp = QKV + (size_t)(b * SEQ + t) * NQKV + hq * HD + 8 * h;
            v4u raw[8]; float ssq = 0.f;
#pragma unroll
            for (int ks = 0; ks < 8; ++ks) { raw[ks] = *(const v4u*)(qp + 16 * ks);
                const float a0 = bflo(raw[ks].x), a1 = bfhi(raw[ks].x), a2 = bflo(raw[ks].y), a3 = bfhi(raw[ks].y), a4 = bflo(raw[ks].z), a5 = bfhi(raw[ks].z), a6 = bflo(raw[ks].w), a7 = bfhi(raw[ks].w);
                ssq += (a0 * a0 + a1 * a1) + (a2 * a2 + a3 * a3) + (a4 * a4 + a5 * a5) + (a6 * a6 + a7 * a7); }
            ssq += __shfl_xor(ssq, 32);
            const float rq = SC / sqrtf(ssq * (1.0f / HD) + EPS);
#pragma unroll
            for (int ks = 0; ks < 8; ++ks) { const int d0 = 16 * ks + 8 * h;
                const f32x4 g0 = *(const f32x4*)(qn + d0), g1 = *(const f32x4*)(qn + d0 + 4), k0 = *(const f32x4*)(kn + d0), k1 = *(const f32x4*)(kn + d0 + 4);
                v4u w;
                w.x = cvtpk(bflo(raw[ks].x) * rq * g0.x * k0.x, bfhi(raw[ks].x) * rq * g0.y * k0.y); w.y = cvtpk(bflo(raw[ks].y) * rq * g0.z * k0.z, bfhi(raw[ks].y) * rq * g0.w * k0.w);
                w.z = cvtpk(bflo(raw[ks].z) * rq * g1.x * k1.x, bfhi(raw[ks].z) * rq * g1.y * k1.y); w.w = cvtpk(bflo(raw[ks].w) * rq * g1.z * k1.z, bfhi(raw[ks].w) * rq * g1.w * k1.w);
                qf[ks] = __builtin_bit_cast(bf16x8, w); }
        }
        float m_run = -5e29f, l_run = 0.f;
        f32x16 o[4];
#pragma unroll
        for (int dt = 0; dt < 4; ++dt)
#pragma unroll
            for (int i = 0; i < 16; ++i) o[dt][i] = 0.f;
        const float nslope = -__builtin_amdgcn_exp2f(-0.5f * (float)(hq + 1)) * L2E, sinkl = sink[hq] * L2E;
        for (int jb = jb0; jb <= jb1; ++jb) {
            if (jb != jb0) __syncthreads();
#pragma unroll
            for (int i = 0; i < 4; ++i) { const int row = srow + 32 * i; const v4u kw = kreg[i];
                const float a0 = bflo(kw.x), a1 = bfhi(kw.x), a2 = bflo(kw.y), a3 = bfhi(kw.y), a4 = bflo(kw.z), a5 = bfhi(kw.z), a6 = bflo(kw.w), a7 = bfhi(kw.w);
                float ss = (a0 * a0 + a1 * a1) + (a2 * a2 + a3 * a3) + (a4 * a4 + a5 * a5) + (a6 * a6 + a7 * a7);
                ss += __shfl_xor(ss, 1); ss += __shfl_xor(ss, 2); ss += __shfl_xor(ss, 4); ss += __shfl_xor(ss, 8);
                const float rk = 1.0f / sqrtf(ss * (1.0f / HD) + EPS);
                v4u w; w.x = cvtpk(a0 * rk, a1 * rk); w.y = cvtpk(a2 * rk, a3 * rk); w.z = cvtpk(a4 * rk, a5 * rk); w.w = cvtpk(a6 * rk, a7 * rk);
                *(LAS v4u*)(lds + AT_K + row * AT_STRIDE + ch * 16) = w; *(LAS v4u*)(lds + AT_V + row * AT_VSTRIDE + ch * 16) = vreg[i]; }
            __syncthreads();
            if (jb < jb1) AT_ISSUE(jb + 1);
#pragma unroll
            for (int hf = 0; hf < 2; ++hf) {
                bool act[2], msk[2];
#pragma unroll
                for (int k2 = 0; k2 < 2; ++k2) { const int sb = jb * 128 + 64 * hf + 32 * k2, dlo = tw - sb - 31, dhi = tw + 31 - sb;
                    act[k2] = !(dlo > 128 || dhi < -128); msk[k2] = (dlo < -128 || dhi > 128); }
                if (!act[0] && !act[1]) continue;
                f32x16 s[2];
#pragma unroll
                for (int k2 = 0; k2 < 2; ++k2) if (act[k2]) {
#pragma unroll
                    for (int i = 0; i < 16; ++i) s[k2][i] = 0.f;
#pragma unroll
                    for (int ks = 0; ks < 8; ++ks) { const bf16x8 a = *(const LAS bf16x8*)(lds + AT_K + (64 * hf + 32 * k2 + r) * AT_STRIDE + (16 * ks + 8 * h) * 2); s[k2] = MFMA32(a, qf[ks], s[k2]); } }
                float bm = -1e30f;
#pragma unroll
                for (int k2 = 0; k2 < 2; ++k2) if (act[k2]) { const float d0 = (float)(t - (jb * 128 + 64 * hf + 32 * k2 + 4 * h));
#pragma unroll
                    for (int i = 0; i < 16; ++i) { const float x = d0 - (float)((i & 3) + 8 * (i >> 2)); float v = __builtin_fmaf(nslope, __builtin_fabsf(x), s[k2][i]);
                        if (msk[k2]) v = (__builtin_fabsf(x) <= 128.0f) ? v : -1e30f;
                        s[k2][i] = v; bm = fmaxf(bm, v); } }
                bm = fmaxf(bm, __shfl_xor(bm, 32));
                const float m_new = fmaxf(m_run, bm), alpha = __builtin_amdgcn_exp2f(m_run - m_new); m_run = m_new; l_run *= alpha;
#pragma unroll
                for (int dt = 0; dt < 4; ++dt)
#pragma unroll
                    for (int i = 0; i < 16; ++i) o[dt][i] *= alpha;
#pragma unroll
                for (int k2 = 0; k2 < 2; ++k2) if (act[k2]) {
                    float ps = 0.f;
#pragma unroll
                    for (int i = 0; i < 16; ++i) { const float p = __builtin_amdgcn_exp2f(s[k2][i] - m_new); s[k2][i] = p; ps += p; }
                    l_run += ps;
#pragma unroll
                    for (int s2 = 0; s2 < 2; ++s2) {
                        v4u pw; pw.x = cvtpk(s[k2][8 * s2 + 0], s[k2][8 * s2 + 1]); pw.y = cvtpk(s[k2][8 * s2 + 2], s[k2][8 * s2 + 3]); pw.z = cvtpk(s[k2][8 * s2 + 4], s[k2][8 * s2 + 5]); pw.w = cvtpk(s[k2][8 * s2 + 6], s[k2][8 * s2 + 7]);
                        const bf16x8 pf = __builtin_bit_cast(bf16x8, pw);
#pragma unroll
                        for (int dt = 0; dt < 4; ++dt) {
                            const LAS unsigned char* vp = lds + AT_V + (64 * hf + 32 * k2 + 16 * s2 + 4 * h + q4) * AT_VSTRIDE + (32 * dt + 16 * blk + 4 * p4) * 2;
                            const s16x4 lo = tr_read(vp), hi4 = tr_read(vp + 8 * AT_VSTRIDE);
                            const bf16x8 a = __builtin_shufflevector(lo, hi4, 0, 1, 2, 3, 4, 5, 6, 7);
                            o[dt] = MFMA32(a, pf, o[dt]); }
                    }
                }
            }
        }
#undef AT_ISSUE
        const float l_tot = l_run + __shfl_xor(l_run, 32);
        const float mf = fmaxf(m_run, sinkl), f = __builtin_amdgcn_exp2f(m_run - mf), sc = f / (l_tot * f + __builtin_amdgcn_exp2f(sinkl - mf));
        bf16* op = AO + (size_t)(b * SEQ + t) * D + hq * HD + 4 * h;
#pragma unroll
        for (int dt = 0; dt < 4; ++dt)
#pragma unroll
            for (int g4 = 0; g4 < 4; ++g4) { v2u w; w.x = cvtpk(o[dt][4 * g4] * sc, o[dt][4 * g4 + 1] * sc); w.y = cvtpk(o[dt][4 * g4 + 2] * sc, o[dt][4 * g4 + 3] * sc);
                *(v2u*)(op + 32 * dt + 8 * g4) = w; }
        __syncthreads();
    }
}

__device__ __forceinline__ void gating_phase(LAS unsigned char* lds, const bf16* Z, bf16* Y, const float* partv, const float* vnorm, const float* w_s, const float* b_s, int bid, int G, int tid) {
    const int lane = tid & 63, wid = __builtin_amdgcn_readfirstlane(tid >> 6), r = lane & 31, h = lane >> 5;
    const int q4 = (lane & 15) >> 2, p4 = lane & 3, blk = (lane >> 4) & 1;
    LAS float* rs = (LAS float*)(lds + 128 * AT_VSTRIDE);
    const int tt = wid >> 1, dt0 = 2 * (wid & 1);
    for (int u = bid; u < 8 * 16 * 16; u += G) {
        const int g = u & 15, c = (u >> 4) & 15, b = u >> 8, row0 = b * SEQ + c * 128;
        { const int ch = tid & 15;
#pragma unroll
          for (int i = 0; i < 4; ++i) { const int row = (tid >> 4) + 32 * i; const v4u w = *(const v4u*)(Z + (size_t)(row0 + row) * (2 * GWD) + GWD + g * 128 + ch * 8); *(LAS v4u*)(lds + row * AT_VSTRIDE + ch * 16) = w; } }
        if (tid < 128) { const f32x4* p = (const f32x4*)(partv + (size_t)(row0 + tid) * 32); float s = 0.f;
#pragma unroll
            for (int i = 0; i < 8; ++i) { const f32x4 v = p[i]; s += (v.x + v.y) + (v.z + v.w); }
            rs[tid] = 1.0f / sqrtf(s * (1.0f / GWD) + EPS); }
        __syncthreads();
        f32x16 acc[2];
#pragma unroll
        for (int dd = 0; dd < 2; ++dd)
#pragma unroll
            for (int i = 0; i < 16; ++i) acc[dd][i] = 0.f;
        const int t = 32 * tt + r;
        const float* wrow = w_s + (size_t)(g * 128 + t) * 128 + 8 * h;
#pragma unroll
        for (int ks = 0; ks < 8; ++ks) {
            const f32x4 w0 = *(const f32x4*)(wrow + 16 * ks), w1 = *(const f32x4*)(wrow + 16 * ks + 4);
            const f32x4 r0 = *(const LAS f32x4*)(rs + 16 * ks + 8 * h), r1 = *(const LAS f32x4*)(rs + 16 * ks + 8 * h + 4);
            v4u bw; bw.x = cvtpk(w0.x * r0.x, w0.y * r0.y); bw.y = cvtpk(w0.z * r0.z, w0.w * r0.w); bw.z = cvtpk(w1.x * r1.x, w1.y * r1.y); bw.w = cvtpk(w1.z * r1.z, w1.w * r1.w);
            const bf16x8 bfr = __builtin_bit_cast(bf16x8, bw);
#pragma unroll
            for (int dd = 0; dd < 2; ++dd) {
                const LAS unsigned char* vp = lds + (16 * ks + 8 * h + q4) * AT_VSTRIDE + (32 * (dt0 + dd) + 16 * blk + 4 * p4) * 2;
                const s16x4 lo = tr_read(vp), hi4 = tr_read(vp + 4 * AT_VSTRIDE);
                const bf16x8 a = __builtin_shufflevector(lo, hi4, 0, 1, 2, 3, 4, 5, 6, 7);
                acc[dd] = MFMA32(a, bfr, acc[dd]); }
        }
        const float bias = b_s[g * 128 + t];
        const bf16* up = Z + (size_t)(row0 + t) * (2 * GWD) + g * 128 + 4 * h; bf16* yp = Y + (size_t)(row0 + t) * GWD + g * 128 + 4 * h; const float* gvp = vnorm + g * 128 + 4 * h;
#pragma unroll
        for (int dd = 0; dd < 2; ++dd)
#pragma unroll
            for (int g4 = 0; g4 < 4; ++g4) { const int d = 32 * (dt0 + dd) + 8 * g4; const f32x4 gv = *(const f32x4*)(gvp + d); const v2u uw = *(const v2u*)(up + d);
                const float y0 = bflo(uw.x) * (acc[dd][4 * g4] * gv.x + bias), y1 = bfhi(uw.x) * (acc[dd][4 * g4 + 1] * gv.y + bias), y2 = bflo(uw.y) * (acc[dd][4 * g4 + 2] * gv.z + bias), y3 = bfhi(uw.y) * (acc[dd][4 * g4 + 3] * gv.w + bias);
                v2u w; w.x = cvtpk(y0, y1); w.y = cvtpk(y2, y3); *(v2u*)(yp + d) = w; }
        __syncthreads();
    }
}

struct Args { const float* in[21]; float* out; unsigned char* ws; int ph_lo, ph_hi; };

__global__ void __launch_bounds__(NWAVES * 64, 2) mega_fwd(Args args) {
    extern __shared__ __attribute__((aligned(16))) unsigned char lds_raw[];
    LAS unsigned char* lds = (LAS unsigned char*)lds_raw;
    volatile LAS unsigned* MISC = (volatile LAS unsigned*)(lds + MISC_OFF);
    const int tid = threadIdx.x, lane = tid & 63, wave = __builtin_amdgcn_readfirstlane(tid >> 6);
    const int G = gridDim.x, bid = blockIdx.x;
    const int gw = bid * NWAVES + wave, NGW = G * NWAVES;
    const int gt = bid * (NWAVES * 64) + tid, NGT = G * NWAVES * 64;
    unsigned char* ws = args.ws;
    gu32* ctl = (gu32*)(ws + WS_CTL);
    for (int u = tid; u < (LDS_BYTES - LDSCTL_OFF) / 4; u += NWAVES * 64) ((LAS unsigned*)(lds + LDSCTL_OFF))[u] = 0u;
    __syncthreads();
    XcdBarrier bar; bar.bar = (unsigned*)(ctl + CW_BAR); bar.x = 0; bar.st = nullptr;
    if (N_LAUNCHES == 1) bar = xcd_barrier_post((unsigned*)(ctl + CW_BAR), MISC + 8);
#define GRID_BAR() do { if (N_LAUNCHES == 1) xcd_barrier(bar); } while (0)
    const int lo = args.ph_lo, hi = args.ph_hi;
#ifdef DBG_REPEAT
    const int dbg_nrep = (args.ph_hi > 100) ? 1 : 2;
#endif
#ifdef DBG_ONLY
#define IN(k) ((k) == DBG_ONLY && lo <= (k) && (k) < hi)
#else
#define IN(k) (lo <= (k) && (k) < hi)
#endif
#define BOTH(k) (IN(k) && IN((k) + 1))
#ifdef DBG_REPEAT
#define REP(k) _Pragma("nounroll") for (int rep_ = 0; rep_ < (((k) == DBG_REPEAT) ? dbg_nrep : 1); ++rep_)
#else
#define REP(k)
#endif

    const float* x_in = args.in[0];
    float* xout = args.out;
    bf16* Wqkv_t = (bf16*)(ws + WS_WQKV); bf16* Wo_t = (bf16*)(ws + WS_WO); bf16* Wgu_t = (bf16*)(ws + WS_WGU); bf16* Wd_t = (bf16*)(ws + WS_WD);
    bf16* Win_t = (bf16*)(ws + WS_WIN); bf16* Wout_t = (bf16*)(ws + WS_WOUT); bf16* Wegu_t = (bf16*)(ws + WS_WEGU); bf16* Wed_t = (bf16*)(ws + WS_WED);
    bf16* HB = (bf16*)(ws + WS_HB); bf16* QKV = (bf16*)(ws + WS_QKV); bf16* AO = (bf16*)(ws + WS_AO); bf16* HFF = (bf16*)(ws + WS_HFF);
    bf16* Z = (bf16*)(ws + WS_Z); bf16* Y = (bf16*)(ws + WS_Y); bf16* HS = (bf16*)(ws + WS_HS); bf16* HE = (bf16*)(ws + WS_HE); bf16* YS = HS;
    float* rstd0 = (float*)(ws + WS_RSTD0); float* rstd1 = (float*)(ws + WS_RSTD1); float* rstd2 = (float*)(ws + WS_RSTD2);
    float* roww = (float*)(ws + WS_ROWW); int* texp_g = (int*)(ws + WS_TEXP);
    unsigned* route = (unsigned*)(ws + WS_ROUTE); float* part = (float*)(ws + WS_PART); float* partv = (float*)(ws + WS_PARTV);

#if USE_SIMPLE_GEMM
#define RUN_GEMM(EPI, SCHED, g, S, E) pg8::gemm_phase_simple<EPI, SCHED>(g, S, E)
#else
#define RUN_GEMM(EPI, SCHED, g, S, E) pg8::gemm_phase<EPI, SCHED, PG8_ALIGN_BF, true>(lds + RING_OFF, g, S, E)
#endif
#define RUN_GEMM_F8(EPI, SCHED, g, S, E) pg8::gemm_phase<EPI, SCHED, PG8_ALIGN_F8, true, 1>(lds + RING_OFF, g, S, E)
#define RUN_GEMM_F6(EPI, SCHED, g, S, E) pg8::gemm_phase<EPI, SCHED, PG8_ALIGN_F8, true, 2>(lds + RING_OFF, g, S, E)
#define RUN_GEMM_F6B(EPI, SCHED, g, S, E) pg8::gemm_phase<EPI, SCHED, PG8_ALIGN_F8, true, 3>(lds + RING_OFF, g, S, E)

    if (IN(0)) REP(0) {
        {
            DensePtrs P{args.in[2], args.in[6], args.in[8], args.in[9], args.in[11], args.in[15], args.in[1], args.in[7], args.in[10], Wqkv_t, Wo_t, Wgu_t, Wd_t, Win_t, Wout_t};
            DenseDesc d0, d1; f32x4 v0[16], v1[16], g0[4], g1[4];
            int it = gw;
#define DENSE_ISSUE(b, idx) do { const int ix0_ = (idx), ix_ = ix0_ < NDENSE2 ? ix0_ : NDENSE2 - 1; dense_desc(ix_, P, d##b); dense_load(d##b, v##b, g##b, lane); } while (0)
            DENSE_ISSUE(0, it);
            for (;;) {
                if (it >= NDENSE2) break; DENSE_ISSUE(1, it + NGW); dense_store(d0, v0, g0, lane); it += NGW;
                if (it >= NDENSE2) break; DENSE_ISSUE(0, it + NGW); dense_store(d1, v1, g1, lane); it += NGW;
            }
#undef DENSE_ISSUE
        }
        for (int m = gw; m < M; m += NGW) {
            const GAS f32x4* xr = (const GAS f32x4*)(x_in + (size_t)m * D) + lane;
            f32x4 v[8]; float s = 0.f;
#pragma unroll
            for (int j = 0; j < 8; ++j) { v[j] = xr[64 * j]; s += (v[j].x * v[j].x + v[j].y * v[j].y) + (v[j].z * v[j].z + v[j].w * v[j].w); }
            const float tot = wave_sum(s);
            if (lane == 0) rstd0[m] = 1.0f / sqrtf(tot * (1.0f / D) + EPS);
            GAS v2u* o8 = (GAS v2u*)(HB + (size_t)m * D) + lane;
#pragma unroll
            for (int j = 0; j < 8; ++j) { v2u w; w.x = pk2(v[j].x, v[j].y); w.y = pk2(v[j].z, v[j].w); o8[64 * j] = w; }
        }
        if (BOTH(0)) GRID_BAR();
    }

    if (IN(1)) REP(1) {
        pg8::Gemm g{HB, Wqkv_t, M, NQKV, D, D}; pg8::StaticOrder S; S.init(M, NQKV, G, bid);
        pg8::EpiRowScale E{QKV, NQKV, rstd0, 1.0f};
        RUN_GEMM(pg8::EpiRowScale, pg8::StaticOrder, g, S, E);
        if (BOTH(1)) GRID_BAR();
    }

    if (IN(2)) REP(2) {
        attn_phase(lds + RING_OFF, QKV, AO, args.in[3], args.in[4], args.in[5], bid, G, tid);
        if (BOTH(2)) GRID_BAR();
    }

    if (IN(3)) REP(3) {
        pg8::Gemm g{AO, Wo_t, M, D, D, D}; pg8::StaticOrder S; S.init(M, D, G, bid);
        typedef pg8::EpiRes<false, false, true, true> Epi3; Epi3 E{nullptr, HB, nullptr, HB, part, D};
        RUN_GEMM(Epi3, pg8::StaticOrder, g, S, E);
        if (BOTH(3)) GRID_BAR();
    }
    if (IN(4)) REP(4) {
        for (int r = gt; r < M; r += NGT) { const f32x4* p = (const f32x4*)(part + (size_t)r * 32); float s = 0.f;
#pragma unroll
            for (int i = 0; i < 8; ++i) { const f32x4 v = p[i]; s += (v.x + v.y) + (v.z + v.w); }
            rstd1[r] = 1.0f / sqrtf(s * (1.0f / D) + EPS); }
        if (BOTH(4)) GRID_BAR();
    }
    if (IN(5)) REP(5) {
        pg8::Gemm g{HB, Wgu_t, M, 2 * FF, D, D}; pg8::StaticOrder S; S.init(M, 2 * FF, G, bid);
        pg8::EpiSwiGLU<0> E{HFF, FF, rstd1, 1.0f};
        const int rounds5 = (S.nwg + G - 1) / G, slot5 = ((bid >> 3) + 4 * (bid & 7)) % (rounds5 + 1);
        S.i0 = 0; S.i1 = slot5;
        RUN_GEMM(pg8::EpiSwiGLU<0>, pg8::StaticOrder, g, S, E);
        {
            const float* wg_ = args.in[18]; const float* wu_ = args.in[19]; const float* wd_ = args.in[20]; unsigned char* dgu_ = (unsigned char*)Wegu_t; unsigned char* dd_ = (unsigned char*)Wed_t;
            {
#ifndef MOE6_RING
#define MOE6_RING 2
#endif
                Moe6Desc d0, d1; f32x4 v0[16], v1[16];
#if MOE6_RING == 3
                Moe6Desc d2; f32x4 v2[16];
#endif
                int it = gw;
#define MOE6_ISSUE(b, idx) do { const int ix0_ = (idx), ix_ = ix0_ < NMOE6 ? ix0_ : NMOE6 - 1; moe6_desc(ix_, wg_, wu_, wd_, dgu_, dd_, d##b); moe6_load(d##b, v##b, lane); } while (0)
#if MOE6_RING == 3
                MOE6_ISSUE(0, it); MOE6_ISSUE(1, it + NGW);
                for (;;) {
                    if (it >= NMOE6) break; MOE6_ISSUE(2, it + 2 * NGW); moe6_store(d0, v0, lane); it += NGW;
                    if (it >= NMOE6) break; MOE6_ISSUE(0, it + 2 * NGW); moe6_store(d1, v1, lane); it += NGW;
                    if (it >= NMOE6) break; MOE6_ISSUE(1, it + 2 * NGW); moe6_store(d2, v2, lane); it += NGW;
                }
#else
                MOE6_ISSUE(0, it);
                for (;;) {
                    if (it >= NMOE6) break; MOE6_ISSUE(1, it + NGW); moe6_store(d0, v0, lane); it += NGW;
                    if (it >= NMOE6) break; MOE6_ISSUE(0, it + NGW); moe6_store(d1, v1, lane); it += NGW;
                }
#endif
#undef MOE6_ISSUE
            }
        }
        S.i0 = slot5; S.i1 = 0x7fffffff;
        RUN_GEMM(pg8::EpiSwiGLU<0>, pg8::StaticOrder, g, S, E);
        if (BOTH(5)) GRID_BAR();
    }
    if (IN(6)) REP(6) {
        pg8::Gemm g{HFF, Wd_t, M, D, FF, FF}; pg8::StaticOrder S; S.init(M, D, G, bid);
        typedef pg8::EpiRes<false, false, true, true> Epi6; Epi6 E{nullptr, HB, nullptr, HB, part, D};
        RUN_GEMM(Epi6, pg8::StaticOrder, g, S, E);
        if (BOTH(6)) GRID_BAR();
    }
    if (IN(7)) REP(7) {
        for (int r = gt; r < M; r += NGT) { const f32x4* p = (const f32x4*)(part + (size_t)r * 32); float s = 0.f;
#pragma unroll
            for (int i = 0; i < 8; ++i) { const f32x4 v = p[i]; s += (v.x + v.y) + (v.z + v.w); }
            rstd2[r] = 1.0f / sqrtf(s * (1.0f / D) + EPS); }
        if (BOTH(7)) GRID_BAR();
    }
    if (IN(8)) REP(8) {
        pg8::Gemm g{HB, Win_t, M, 2 * GWD, D, D}; pg8::StaticOrder S; S.init(M, 2 * GWD, G, bid);
        pg8::EpiGelu E{Z, 2 * GWD, rstd2, partv, GWD / 256};
        RUN_GEMM(pg8::EpiGelu, pg8::StaticOrder, g, S, E);
        if (BOTH(8)) GRID_BAR();
    }
    if (IN(9)) REP(9) {
        gating_phase(lds + RING_OFF, Z, Y, partv, args.in[12], args.in[13], args.in[14], bid, G, tid);
        if (BOTH(9)) GRID_BAR();
    }
    if (IN(10)) REP(10) {
        pg8::Gemm g{Y, Wout_t, M, D, GWD, GWD}; pg8::StaticOrder S; S.init(M, D, G, bid);
        typedef pg8::EpiRes<false, true, false, false> Epi10; Epi10 E{nullptr, HB, xout, nullptr, nullptr, D};
        RUN_GEMM(Epi10, pg8::StaticOrder, g, S, E);
        if (BOTH(10)) GRID_BAR();
    }
    if (IN(11)) REP(11) {
        const float* g3 = args.in[16]; const float* wr_g = args.in[17];
        LAS float* wr = (LAS float*)(lds + RING_OFF);
        for (int i = tid; i < D * NE / 4; i += NWAVES * 64) ((LAS f32x4*)wr)[i] = ((const f32x4*)wr_g)[i];
        __syncthreads();
        for (int m = gw; m < M; m += NGW) {
            const GAS f32x4* xr = (const GAS f32x4*)(xout + (size_t)m * D) + lane;
            float s = 0.f;
#pragma unroll 1
            for (int j = 0; j < 8; ++j) { const f32x4 v = xr[64 * j]; s += (v.x * v.x + v.y * v.y) + (v.z * v.z + v.w * v.w); }
            const float rstd = 1.0f / sqrtf(wave_sum(s) * (1.0f / D) + EPS);
            float lg[NE];
#pragma unroll
            for (int e = 0; e < NE; ++e) lg[e] = 0.f;
            LAS unsigned char* hb = lds + RING_OFF + 65536 + wave * 8192;
#pragma unroll 1
            for (int j = 0; j < 8; ++j) { const f32x4 vv = xr[64 * j]; const f32x4 gg = ((const f32x4*)g3)[lane + 64 * j]; const f32x4 h = vv * rstd * gg;
                { f32x4 hs; hs.x = clamp6(h.x * A6SCALE); hs.y = clamp6(h.y * A6SCALE); hs.z = clamp6(h.z * A6SCALE); hs.w = clamp6(h.w * A6SCALE);
                  *(LAS f32x4*)(hb + 128 * ((lane >> 3) + 8 * j) + 16 * ((lane & 7) ^ ((lane >> 3) & 7))) = hs; }
                const int c0 = 4 * (lane + 64 * j);
#pragma unroll
                for (int i = 0; i < 4; ++i) { const f32x4 w0 = *(const LAS f32x4*)(wr + (c0 + i) * 8), w1 = *(const LAS f32x4*)(wr + (c0 + i) * 8 + 4); const float hv = h[i];
                    lg[0] += hv * w0.x; lg[1] += hv * w0.y; lg[2] += hv * w0.z; lg[3] += hv * w0.w; lg[4] += hv * w1.x; lg[5] += hv * w1.y; lg[6] += hv * w1.z; lg[7] += hv * w1.w; } }
            {
                __builtin_amdgcn_wave_barrier(); asm volatile("s_waitcnt lgkmcnt(0)" ::: "memory");
                v16f_t a6, b6;
#pragma unroll
                for (int c = 0; c < 4; ++c) { const f32x4 t0 = *(const LAS f32x4*)(hb + 128 * lane + 16 * (c ^ (lane & 7))), t1 = *(const LAS f32x4*)(hb + 128 * lane + 16 * ((c + 4) ^ (lane & 7)));
                    a6[4 * c] = t0.x; a6[4 * c + 1] = t0.y; a6[4 * c + 2] = t0.z; a6[4 * c + 3] = t0.w; b6[4 * c] = t1.x; b6[4 * c + 1] = t1.y; b6[4 * c + 2] = t1.z; b6[4 * c + 3] = t1.w; }
                const v6u_t r6 = __builtin_amdgcn_cvt_scalef32_2xpk16_fp6_f32(a6, b6, 1.0f);
                GAS unsigned char* o6 = (GAS unsigned char*)HB + (size_t)m * D + 128 * (lane >> 2) + 16 * (lane & 3);
                v4u o0, o1; o0.x = r6[0]; o0.y = r6[1]; o0.z = r6[2]; o0.w = r6[3]; o1.x = r6[4]; o1.y = r6[5]; o1.z = 0u; o1.w = 0u;
                *(GAS v4u*)o6 = o0; *(GAS v4u*)(o6 + 64) = o1;
                __builtin_amdgcn_wave_barrier(); asm volatile("" ::: "memory");
            }
#pragma unroll
            for (int e = 0; e < NE; ++e) lg[e] = wave_sum(lg[e]);
            int e0 = 0; float v0 = lg[0];
#pragma unroll
            for (int e = 1; e < NE; ++e) if (lg[e] > v0) { v0 = lg[e]; e0 = e; }
            int e1 = -1; float v1 = -3.0e38f;
#pragma unroll
            for (int e = 0; e < NE; ++e) if (e != e0 && lg[e] > v1) { v1 = lg[e]; e1 = e; }
            const float ex = __expf(v1 - v0), w0 = 1.0f / (1.0f + ex), w1 = ex / (1.0f + ex);
            if (lane == 0) {
                const unsigned p0 = __hip_atomic_fetch_add((unsigned*)(ctl + CW_CNT + 64 * e0), 1u, RLX_AGENT);
                const unsigned p1 = __hip_atomic_fetch_add((unsigned*)(ctl + CW_CNT + 64 * e1), 1u, RLX_AGENT);
                v4u ra; ra.x = (unsigned)e0; ra.y = (unsigned)e1; ra.z = p0; ra.w = p1; v4u rb; rb.x = __float_as_uint(w0); rb.y = __float_as_uint(w1); rb.z = 0u; rb.w = 0u;
                *(v4u*)(route + (size_t)m * 8) = ra; *(v4u*)(route + (size_t)m * 8 + 4) = rb; }
        }
        __syncthreads();
        if (BOTH(11)) GRID_BAR();
    }
    int eoff[NE + 1]; int ecnt[NE];
    if (hi > 12) {
        eoff[0] = 0;
#pragma unroll
        for (int e = 0; e < NE; ++e) { ecnt[e] = (int)__hip_atomic_load((unsigned*)(ctl + CW_CNT + 64 * e), RLX_AGENT); eoff[e + 1] = eoff[e] + ((ecnt[e] + 255) & ~255); }
    } else {
#pragma unroll
        for (int e = 0; e < NE; ++e) { ecnt[e] = 0; eoff[e] = 0; } eoff[NE] = 0;
    }
    const int nMt = eoff[NE] >> 8;
    LAS int* texp = (LAS int*)(lds + TEXP_OFF);
    if (IN(12)) REP(12) {
        for (int t = gw; t < M; t += NGW) {
            const v4u ra = *(const v4u*)(route + (size_t)t * 8); const v4u rb = *(const v4u*)(route + (size_t)t * 8 + 4);
            int o0 = 0, o1 = 0;
#pragma unroll
            for (int e = 0; e < NE; ++e) { if ((int)ra.x == e) o0 = eoff[e]; if ((int)ra.y == e) o1 = eoff[e]; }
            const int d0 = o0 + (int)ra.z, d1 = o1 + (int)ra.w;
            const GAS v4u* src = (const GAS v4u*)((unsigned char*)HB + (size_t)t * D) + lane; GAS v4u* q0 = (GAS v4u*)((unsigned char*)HS + (size_t)d0 * D) + lane; GAS v4u* q1 = (GAS v4u*)((unsigned char*)HS + (size_t)d1 * D) + lane;
#pragma unroll
            for (int j = 0; j < 2; ++j) { const v4u v = src[64 * j]; q0[64 * j] = v; q1[64 * j] = v; }
            if (lane == 0) { roww[d0] = __uint_as_float(rb.x); roww[d1] = __uint_as_float(rb.y); }
        }
#pragma unroll
        for (int e = 0; e < NE; ++e) { const int npad = eoff[e + 1] - eoff[e] - ecnt[e];
            for (int i = gw; i < npad; i += NGW) { const int row = eoff[e] + ecnt[e] + i; GAS v4u* q0 = (GAS v4u*)((unsigned char*)HS + (size_t)row * D) + lane;
#pragma unroll
                for (int j = 0; j < 2; ++j) q0[64 * j] = (v4u){0u, 0u, 0u, 0u};
                if (lane == 0) roww[row] = 0.f; } }
        if (BOTH(12)) GRID_BAR();
    }
    if (hi > 13) {
        for (int mt = tid; mt < 144; mt += NWAVES * 64) { int e = 0;
#pragma unroll
            for (int k = 1; k < NE; ++k) if (mt * 256 >= eoff[k]) e = k;
            texp[mt] = e; }
        __syncthreads();
    }
    if (IN(13)) REP(13) {
        pg8::Gemm g{HS, Wegu_t, PMAX, 2 * FE, D / 2, D / 2}; pg8::GroupedOrder S; S.init(nMt, 2 * FE, G, bid, (const LAS int*)texp, WGM13);
        pg8::EpiSwiGLU<2> E{HE, FE, nullptr, 1.0f / (W6SCALE * A6SCALE)};
        RUN_GEMM_F6(pg8::EpiSwiGLU<2>, pg8::GroupedOrder, g, S, E);
        if (BOTH(13)) GRID_BAR();
    }
    const int nwg14 = nMt * (D / 256), L0_14 = (nwg14 / G) * G, R14 = nwg14 - L0_14;
    int ts14 = 1;
    if (R14 > 0) { if (14 * R14 <= G) ts14 = 14; else if (7 * R14 <= G) ts14 = 7; else if (4 * R14 <= G) ts14 = 4; else if (2 * R14 <= G) ts14 = 2; }
    float* PTL = (float*)(ws + WS_PTL);
    if (IN(14)) REP(14) {
        { pg8::Gemm g{HE, Wed_t, PMAX, D, FE / 2, FE / 2}; pg8::GroupedOrder S; S.init(nMt, D, G, bid, (const LAS int*)texp, WGM14); if (ts14 > 1) S.lim = L0_14;
          pg8::EpiRowScale E{YS, D, roww, 1.0f / (W6SCALE_D * H6SCALE)};
          RUN_GEMM_F6B(pg8::EpiRowScale, pg8::GroupedOrder, g, S, E); }
        if (ts14 > 1) { pg8::Gemm g{HE, Wed_t, PMAX, D, FE / 2, FE / 2 / ts14}; pg8::TailOrder S{nMt, D / 256, nwg14, bid, L0_14, R14 * ts14, ts14, FE / 2 / ts14, WGM14, (const LAS int*)texp};
          pg8::EpiPartial E{PTL};
          RUN_GEMM_F6B(pg8::EpiPartial, pg8::TailOrder, g, S, E); }
        if (BOTH(14)) GRID_BAR();
    }
    if (IN(15)) REP(15) {
        if (ts14 > 1) {
            for (int idx = gt; idx < R14 * 16384; idx += NGT) {
                const int q = idx >> 14, rem = idx & 16383, rowl = rem >> 6, c4 = (rem & 63) * 4; int pm, pn; pg8::map_unit(L0_14 + q, nMt, D / 256, nwg14, pm, pn, WGM14);
                const float* p = PTL + (size_t)q * ts14 * 65536 + rowl * 256 + c4; f32x4 a = *(const f32x4*)p;
                for (int ch = 1; ch < ts14; ++ch) a += *(const f32x4*)(p + (size_t)ch * 65536);
                const int row = pm * 256 + rowl; const float w = roww[row] * (1.0f / (W6SCALE_D * H6SCALE));
                v2u o; o.x = pk2(a.x * w, a.y * w); o.y = pk2(a.z * w, a.w * w); *(v2u*)(YS + (size_t)row * D + pn * 256 + c4) = o; }
        }
        if (BOTH(15)) GRID_BAR();
    }
    if (IN(16)) REP(16) {
        for (int t = gw; t < M; t += NGW) {
            const v4u ra = *(const v4u*)(route + (size_t)t * 8);
            int o0 = 0, o1 = 0;
#pragma unroll
            for (int e = 0; e < NE; ++e) { if ((int)ra.x == e) o0 = eoff[e]; if ((int)ra.y == e) o1 = eoff[e]; }
            const int d0 = o0 + (int)ra.z, d1 = o1 + (int)ra.w;
            const GAS v4u* y0 = (const GAS v4u*)(YS + (size_t)d0 * D) + lane; const GAS v4u* y1 = (const GAS v4u*)(YS + (size_t)d1 * D) + lane;
            GAS f32x4* xo = (GAS f32x4*)(xout + (size_t)t * D);
#pragma unroll
            for (int j = 0; j < 4; ++j) { const v4u a = y0[64 * j], b = y1[64 * j]; const int c = 2 * (lane + 64 * j);
                f32x4 p = xo[c], q = xo[c + 1];
                p.x += bflo(a.x) + bflo(b.x); p.y += bfhi(a.x) + bfhi(b.x); p.z += bflo(a.y) + bflo(b.y); p.w += bfhi(a.y) + bfhi(b.y);
                q.x += bflo(a.z) + bflo(b.z); q.y += bfhi(a.z) + bfhi(b.z); q.z += bflo(a.w) + bflo(b.w); q.w += bfhi(a.w) + bfhi(b.w);
                xo[c] = p; xo[c + 1] = q; }
        }
    }
#undef IN
#undef BOTH
}

extern "C" void kernel_launch(void* const* d_in, const int* in_sizes, int n_in, void* d_out, int out_size, void* d_ws, size_t ws_size, hipStream_t stream) {
    static int grid = 0;
    if (grid == 0) {
        if (n_in != 21 || in_sizes[0] != M * D || out_size != M * D || ws_size < WS_END) { fprintf(stderr, "kernel_launch: unexpected shapes (n_in %d, in0 %d, out %d, ws %zu < %zu)\n", n_in, n_in > 0 ? in_sizes[0] : -1, out_size, ws_size, (size_t)WS_END); grid = -1; return; }
        int dev = 0, cus = 0, per_cu = 0;
        if (hipGetDevice(&dev) != hipSuccess || hipDeviceGetAttribute(&cus, hipDeviceAttributeMultiprocessorCount, dev) != hipSuccess) { grid = -1; return; }
        if (hipFuncSetAttribute((const void*)mega_fwd, hipFuncAttributeMaxDynamicSharedMemorySize, LDS_BYTES) != hipSuccess) { fprintf(stderr, "kernel_launch: hipFuncSetAttribute failed\n"); grid = -1; return; }
        if (hipOccupancyMaxActiveBlocksPerMultiprocessor(&per_cu, (const void*)mega_fwd, NWAVES * 64, LDS_BYTES) != hipSuccess || per_cu < 1) fprintf(stderr, "kernel_launch: occupancy query reports %d\n", per_cu);
        (void)hipGetLastError();
        grid = cus;
    }
    if (grid < 0) return;
    if (hipMemsetAsync((char*)d_ws + WS_CTL, 0, CTL_ZERO_BYTES, stream) != hipSuccess) return;
    Args a{};
    for (int i = 0; i < 21; ++i) a.in[i] = (const float*)d_in[i];
    a.out = (float*)d_out; a.ws = (unsigned char*)d_ws;
    for (int li = 0; li < N_LAUNCHES; ++li) {
        a.ph_lo = (N_LAUNCHES == 1) ? 0 : li; a.ph_hi = (N_LAUNCHES == 1) ? N_PHASES : li + 1;
        hipLaunchKernelGGL(mega_fwd, dim3(grid), dim3(NWAVES * 64), LDS_BYTES, stream, a);
        const hipError_t le = hipPeekAtLastError();
        if (le != hipSuccess) { fprintf(stderr, "kernel_launch: launch %d failed: %s\n", li, hipGetErrorName(le)); break; }
    }
}
```

```cpp
#include <hip/hip_runtime.h>
#include <cstdio>
#include <cstdint>

#ifndef USE_SIMPLE_GEMM
#define USE_SIMPLE_GEMM 0
#endif
#ifndef MK_N_LAUNCHES
#define MK_N_LAUNCHES 1
#endif
#ifndef WGM13
#define WGM13 4
#endif
#ifndef WGM14
#define WGM14 4
#endif
#ifndef PG8_ALIGN_F8
#define PG8_ALIGN_F8 true
#endif
#ifndef PG8_ALIGN_BF
#define PG8_ALIGN_BF true
#endif

namespace pg8 {
#define PG8_LAS __attribute__((address_space(3)))
typedef unsigned short bf16_t;
typedef short bf16x8 __attribute__((ext_vector_type(8)));
typedef float f32x4 __attribute__((ext_vector_type(4)));
typedef unsigned u32x4 __attribute__((ext_vector_type(4)));
typedef unsigned u32x2 __attribute__((ext_vector_type(2)));
constexpr int BM = 256, BK = 64, HALF = 128, HTB = HALF * BK * 2  , STAGE_BYTES = 8 * HTB, NXCD = 8, WGM = 4;

__host__ __device__ __forceinline__ int lds_byte(int r, int c) { const int st = (r >> 4) * 2 + (c >> 5), rr = r & 15, cc = c & 31, ob = rr * 64 + cc * 2; return st * 1024 + (ob ^ (((ob >> 9) & 1) << 5)); }
__host__ __device__ __forceinline__ void stage_rc(int b, int& R, int& C) { const int st = b / 1024, sb = b % 1024, swz = sb ^ (((sb >> 9) & 1) << 5); R = (st >> 1) * 16 + swz / 64; C = (st & 1) * 32 + (swz % 64) / 2; }
__host__ __device__ __forceinline__ int perm32(int rho) { const int n = rho >> 4, i = rho & 15; return 8 * (i >> 2) + 4 * n + (i & 3); }

struct Unit { int pm, pn, pb, ko, aux; };
struct Gemm { const bf16_t* A; const bf16_t* Bt; int M, N, K, Kl; };
__host__ __device__ __forceinline__ void map_unit(int L, int nM, int nN, int nwg, int& pm, int& pn, int WGM_ = WGM) {
    int wgid = L; { const int q = nwg / NXCD, r = nwg % NXCD, xcd = wgid % NXCD, off = wgid / NXCD; wgid = (xcd < r ? xcd * (q + 1) : r * (q + 1) + (xcd - r) * q) + off; }
    const int nig = WGM_ * nN, gid = wgid / nig, fm = gid * WGM_, gsz = (nM - fm) < WGM_ ? (nM - fm) : WGM_;
    pm = fm + ((wgid % nig) % gsz); pn = (wgid % nig) / gsz; }

struct StaticOrder {
    int nM, nN, nwg, G, c, i0, i1;
    __host__ __device__ void init(int M, int N, int G_, int c_) { nM = M / BM; nN = N / BM; nwg = nM * nN; G = G_; c = c_; i0 = 0; i1 = 0x7fffffff; }
    __host__ __device__ bool next(int i, Unit& u) const {
        if (i >= i1 - i0) return false;
        const long L = (long)(i + i0) * G + c; if (L >= nwg) return false;
        int wgid = (int)L; { const int q = nwg / NXCD, r = nwg % NXCD, xcd = wgid % NXCD, off = wgid / NXCD; wgid = (xcd < r ? xcd * (q + 1) : r * (q + 1) + (xcd - r) * q) + off; }
        const int nig = WGM * nN, gid = wgid / nig, fm = gid * WGM, gsz = (nM - fm) < WGM ? (nM - fm) : WGM;
        u.pm = fm + ((wgid % nig) % gsz); u.pn = (wgid % nig) / gsz; u.pb = u.pn; u.ko = 0; u.aux = 0; return true;
    }
    __device__ __forceinline__ void a_ready(const Unit&) const {}
    __device__ __forceinline__ void done(const Unit&) const {}
};
struct GroupedOrder {
    int nM, nN, nwg, G, c, lim, wgm; const PG8_LAS int* texp;
    __device__ void init(int nM_, int N, int G_, int c_, const PG8_LAS int* t, int wgm_) { nM = nM_; nN = N / BM; nwg = nM * nN; G = G_; c = c_; texp = t; lim = nwg; wgm = wgm_; }
    __device__ bool next(int i, Unit& u) const {
        const long L = (long)i * G + c; if (L >= lim) return false;
        map_unit((int)L, nM, nN, nwg, u.pm, u.pn, wgm); u.pb = __builtin_amdgcn_readfirstlane(texp[u.pm]) * nN + u.pn; u.ko = 0; u.aux = 0; return true;
    }
    __device__ __forceinline__ void a_ready(const Unit&) const {}
    __device__ __forceinline__ void done(const Unit&) const {}
};
struct TailOrder {
    int nM, nN, nwg, c, L0, nsub, s, klen, wgm; const PG8_LAS int* texp;
    __device__ bool next(int i, Unit& u) const {
        if (i != 0 || c >= nsub) return false;
        const int q = c / s, ch = c - q * s;
        map_unit(L0 + q, nM, nN, nwg, u.pm, u.pn, wgm); u.pb = __builtin_amdgcn_readfirstlane(texp[u.pm]) * nN + u.pn; u.ko = ch * klen; u.aux = c; return true;
    }
    __device__ __forceinline__ void a_ready(const Unit&) const {}
    __device__ __forceinline__ void done(const Unit&) const {}
};

__device__ __forceinline__ unsigned cvt_pk_bf16(float lo, float hi) { unsigned r; asm volatile("v_cvt_pk_bf16_f32 %0, %1, %2" : "=v"(r) : "v"(lo), "v"(hi)); return r; }
__device__ __forceinline__ float sigmoid_f(float x) { return __builtin_amdgcn_rcpf(1.0f + __builtin_amdgcn_exp2f(-1.4426950408889634f * x)); }
__device__ __forceinline__ float silu_f(float x) { return x * sigmoid_f(x); }
__device__ __forceinline__ float gelu_tanh_f(float x) { const float in = 0.7978845608028654f * (x + 0.044715f * x * x * x); return x * sigmoid_f(2.0f * in); }

struct EpiRowScale {
    static constexpr bool PERM = true, AFTER_DRAIN = false;
    bf16_t* O; int ldc; const float* rs; float cs;
    __device__ __forceinline__ void operator()(const f32x4 (&acc)[2][2][4][2], const Unit& u, int wr, int wc, int fr, int fq) const {
        const int row0 = u.pm * BM + wr * 64 + fr, col0 = u.pn * BM + wc * 32 + 8 * fq;
#pragma unroll
        for (int ai = 0; ai < 2; ++ai)
#pragma unroll
            for (int m = 0; m < 4; ++m) { const int row = row0 + ai * HALF + m * 16; const float s = rs[row] * cs; bf16_t* rowp = O + (size_t)row * ldc + col0;
#pragma unroll
                for (int bj = 0; bj < 2; ++bj) { const f32x4 v0 = acc[ai][bj][m][0] * s, v1 = acc[ai][bj][m][1] * s;
                    u32x4 w; w.x = cvt_pk_bf16(v0[0], v0[1]); w.y = cvt_pk_bf16(v0[2], v0[3]); w.z = cvt_pk_bf16(v1[0], v1[1]); w.w = cvt_pk_bf16(v1[2], v1[3]);
                    *(u32x4*)(rowp + bj * HALF) = w; } }
    }
};
struct EpiPartial {
    static constexpr bool PERM = false, AFTER_DRAIN = false;
    float* P;
    __device__ __forceinline__ void operator()(const f32x4 (&acc)[2][2][4][2], const Unit& u, int wr, int wc, int fr, int fq) const {
        float* base = P + (size_t)u.aux * 65536 + (size_t)(wr * 64 + fr) * 256 + wc * 32 + 4 * fq;
#pragma unroll
        for (int ai = 0; ai < 2; ++ai)
#pragma unroll
            for (int m = 0; m < 4; ++m)
#pragma unroll
                for (int bj = 0; bj < 2; ++bj)
#pragma unroll
                    for (int n = 0; n < 2; ++n) *(f32x4*)(base + (size_t)(ai * HALF + m * 16) * 256 + bj * HALF + n * 16) = acc[ai][bj][m][n];
    }
};
template <int OUT8  > struct EpiSwiGLU {
    static constexpr bool PERM = true, AFTER_DRAIN = false;
    bf16_t* O; int ldc; const float* rs; float cs;
    __device__ __forceinline__ void operator()(const f32x4 (&acc)[2][2][4][2], const Unit& u, int wr, int wc, int fr, int fq) const {
        const int row0 = u.pm * BM + wr * 64 + fr, col0 = u.pn * HALF + wc * 32 + 8 * fq;
#pragma unroll
        for (int ai = 0; ai < 2; ++ai) {
            float hh[4][8];
#pragma unroll
            for (int m = 0; m < 4; ++m) { const int row = row0 + ai * HALF + m * 16; const float s = rs ? rs[row] : cs;
                const float ns = -1.4426950408889634f * s, c2 = s * s * (OUT8 == 1 ? 8.0f : (OUT8 == 2 ? 2.5f : 1.0f));
                float h[8];
#pragma unroll
                for (int n = 0; n < 2; ++n) { const f32x4 g4 = acc[ai][0][m][n], u4 = acc[ai][1][m][n]; const f32x4 t4 = g4 * ns; f32x4 e4;
                    e4[0] = __builtin_amdgcn_exp2f(t4[0]); e4[1] = __builtin_amdgcn_exp2f(t4[1]); e4[2] = __builtin_amdgcn_exp2f(t4[2]); e4[3] = __builtin_amdgcn_exp2f(t4[3]);
                    const f32x4 d4 = e4 + 1.0f; f32x4 r4;
                    r4[0] = __builtin_amdgcn_rcpf(d4[0]); r4[1] = __builtin_amdgcn_rcpf(d4[1]); r4[2] = __builtin_amdgcn_rcpf(d4[2]); r4[3] = __builtin_amdgcn_rcpf(d4[3]);
                    const f32x4 h4 = (g4 * u4) * (r4 * c2);
#pragma unroll
                    for (int j = 0; j < 4; ++j) h[n * 4 + j] = OUT8 == 1 ? __builtin_amdgcn_fmed3f(h4[j], -448.0f, 448.0f) : (OUT8 == 2 ? __builtin_amdgcn_fmed3f(h4[j], -28.0f, 28.0f) : h4[j]); }
                if (OUT8 == 1) {
                    int lo_ = __builtin_amdgcn_cvt_pk_fp8_f32(h[0], h[1], 0, false); lo_ = __builtin_amdgcn_cvt_pk_fp8_f32(h[2], h[3], lo_, true);
                    int hi_ = __builtin_amdgcn_cvt_pk_fp8_f32(h[4], h[5], 0, false); hi_ = __builtin_amdgcn_cvt_pk_fp8_f32(h[6], h[7], hi_, true);
                    u32x2 w; w.x = (unsigned)lo_; w.y = (unsigned)hi_; *(u32x2*)((unsigned char*)O + (size_t)row * ldc + col0) = w; }
                else if (OUT8 == 2) {
#pragma unroll
                    for (int e = 0; e < 8; ++e) hh[m][e] = h[e]; }
                else { u32x4 w; w.x = cvt_pk_bf16(h[0], h[1]); w.y = cvt_pk_bf16(h[2], h[3]); w.z = cvt_pk_bf16(h[4], h[5]); w.w = cvt_pk_bf16(h[6], h[7]);
                    *(u32x4*)(O + (size_t)row * ldc + col0) = w; } }
            if (OUT8 == 2) {
                typedef float v16f_ __attribute__((ext_vector_type(16))); typedef unsigned v6u_ __attribute__((ext_vector_type(6)));
                v16f_ a, b;
#pragma unroll
                for (int e = 0; e < 8; ++e) { unsigned x0 = __builtin_bit_cast(unsigned, hh[0][e]), x1 = __builtin_bit_cast(unsigned, hh[1][e]), x2 = __builtin_bit_cast(unsigned, hh[2][e]), x3 = __builtin_bit_cast(unsigned, hh[3][e]);
                    const auto r02 = __builtin_amdgcn_permlane32_swap(x0, x2, false, false); x0 = r02[0]; x2 = r02[1];
                    const auto r13 = __builtin_amdgcn_permlane32_swap(x1, x3, false, false); x1 = r13[0]; x3 = r13[1];
                    const auto r01 = __builtin_amdgcn_permlane16_swap(x0, x1, false, false); x0 = r01[0]; x1 = r01[1];
                    const auto r23 = __builtin_amdgcn_permlane16_swap(x2, x3, false, false); x2 = r23[0]; x3 = r23[1];
                    a[e] = __builtin_bit_cast(float, x0); a[8 + e] = __builtin_bit_cast(float, x1); b[e] = __builtin_bit_cast(float, x2); b[8 + e] = __builtin_bit_cast(float, x3); }
                const v6u_ r = __builtin_amdgcn_cvt_scalef32_2xpk16_bf6_f32(a, b, 1.0f);
                unsigned char* q = (unsigned char*)O + (size_t)(row0 + ai * HALF + 16 * fq) * ldc + u.pn * HALF + wc * 16;
                const bool hi6 = (fr >> 2) & 1;
                u32x4 o0, o1; o0.x = r[0]; o0.y = r[1]; o0.z = r[2]; o0.w = r[3]; o1.x = hi6 ? 0u : r[4]; o1.y = hi6 ? 0u : r[5]; o1.z = hi6 ? r[4] : 0u; o1.w = hi6 ? r[5] : 0u;
                *(u32x4*)q = o0; *(u32x4*)(q + 64) = o1; }
        }
    }
};
struct EpiGelu {
    static constexpr bool PERM = true, AFTER_DRAIN = false;
    bf16_t* O; int ldc; const float* rs; float* part; int pn_stat;
    __device__ __forceinline__ void operator()(const f32x4 (&acc)[2][2][4][2], const Unit& u, int wr, int wc, int fr, int fq) const {
        const int row0 = u.pm * BM + wr * 64 + fr, col0 = u.pn * BM + wc * 32 + 8 * fq;
        const bool st = u.pn >= pn_stat;
        const float A = -0.044715f * 1.5957691216057308f * 1.4426950408889634f, B = -1.5957691216057308f * 1.4426950408889634f;
#pragma unroll
        for (int ai = 0; ai < 2; ++ai)
#pragma unroll
            for (int m = 0; m < 4; ++m) { const int row = row0 + ai * HALF + m * 16; const float s = rs[row]; bf16_t* rowp = O + (size_t)row * ldc + col0; f32x4 sq = (f32x4){0.f, 0.f, 0.f, 0.f};
#pragma unroll
                for (int bj = 0; bj < 2; ++bj) { f32x4 z[2];
#pragma unroll
                    for (int n = 0; n < 2; ++n) { const f32x4 v4 = acc[ai][bj][m][n] * s; const f32x4 a4 = v4 * ((v4 * v4) * A + B); f32x4 e4;
                        e4[0] = __builtin_amdgcn_exp2f(a4[0]); e4[1] = __builtin_amdgcn_exp2f(a4[1]); e4[2] = __builtin_amdgcn_exp2f(a4[2]); e4[3] = __builtin_amdgcn_exp2f(a4[3]);
                        const f32x4 d4 = e4 + 1.0f; f32x4 r4;
                        r4[0] = __builtin_amdgcn_rcpf(d4[0]); r4[1] = __builtin_amdgcn_rcpf(d4[1]); r4[2] = __builtin_amdgcn_rcpf(d4[2]); r4[3] = __builtin_amdgcn_rcpf(d4[3]);
                        z[n] = v4 * r4; sq += z[n] * z[n]; }
                    u32x4 w; w.x = cvt_pk_bf16(z[0][0], z[0][1]); w.y = cvt_pk_bf16(z[0][2], z[0][3]); w.z = cvt_pk_bf16(z[1][0], z[1][1]); w.w = cvt_pk_bf16(z[1][2], z[1][3]);
                    *(u32x4*)(rowp + bj * HALF) = w; }
                float ssq = (sq[0] + sq[1]) + (sq[2] + sq[3]);
                ssq += __shfl_xor(ssq, 16); ssq += __shfl_xor(ssq, 32);
                if (st && fq == 0) part[(size_t)row * 32 + (u.pn - pn_stat) * 4 + wc] = ssq; }
    }
};
template <bool BASE_F32, bool OUT_F32, bool OUT_BF16, bool STATS>
struct EpiRes {
    static constexpr bool PERM = true, AFTER_DRAIN = false;
    const float* basef; const bf16_t* baseb; float* outf; bf16_t* outb; float* part; int ldc;
    __device__ __forceinline__ void operator()(const f32x4 (&acc)[2][2][4][2], const Unit& u, int wr, int wc, int fr, int fq) const {
        const int row0 = u.pm * BM + wr * 64 + fr, col0 = u.pn * BM + wc * 32 + 8 * fq;
#pragma unroll
        for (int ai = 0; ai < 2; ++ai)
#pragma unroll
            for (int m = 0; m < 4; ++m) { const int row = row0 + ai * HALF + m * 16; const size_t off = (size_t)row * ldc + col0; float ssq = 0.f;
#pragma unroll
                for (int bj = 0; bj < 2; ++bj) { const size_t o2 = off + bj * HALF; f32x4 b0, b1;
                    if (BASE_F32) { b0 = *(const f32x4*)(basef + o2); b1 = *(const f32x4*)(basef + o2 + 4); }
                    else { const u32x4 w = *(const u32x4*)(baseb + o2);
                        b0 = (f32x4){__uint_as_float(w.x << 16), __uint_as_float(w.x & 0xffff0000u), __uint_as_float(w.y << 16), __uint_as_float(w.y & 0xffff0000u)};
                        b1 = (f32x4){__uint_as_float(w.z << 16), __uint_as_float(w.z & 0xffff0000u), __uint_as_float(w.w << 16), __uint_as_float(w.w & 0xffff0000u)}; }
                    const f32x4 o0 = b0 + acc[ai][bj][m][0], o1 = b1 + acc[ai][bj][m][1];
                    if (OUT_F32) { *(f32x4*)(outf + o2) = o0; *(f32x4*)(outf + o2 + 4) = o1; }
                    if (OUT_BF16) { u32x4 w; w.x = cvt_pk_bf16(o0[0], o0[1]); w.y = cvt_pk_bf16(o0[2], o0[3]); w.z = cvt_pk_bf16(o1[0], o1[1]); w.w = cvt_pk_bf16(o1[2], o1[3]); *(u32x4*)(outb + o2) = w; }
                    if (STATS) ssq += ((o0[0] * o0[0] + o0[1] * o0[1]) + (o0[2] * o0[2] + o0[3] * o0[3])) + ((o1[0] * o1[0] + o1[1] * o1[1]) + (o1[2] * o1[2] + o1[3] * o1[3])); }
                if (STATS) { ssq += __shfl_xor(ssq, 16); ssq += __shfl_xor(ssq, 32); if (fq == 0) part[(size_t)row * 32 + u.pn * 4 + wc] = ssq; }
                asm volatile("" ::: "memory"); }
    }
};

typedef int v8i_t __attribute__((ext_vector_type(8)));
typedef int v4i_t __attribute__((ext_vector_type(4)));
typedef int v6i_t __attribute__((ext_vector_type(6)));
typedef int v2i_t __attribute__((ext_vector_type(2)));
__device__ __forceinline__ f32x4 mma_f8(bf16x8 b0, bf16x8 b1, bf16x8 a0, bf16x8 a1, f32x4 c) {
    const v4i_t x0 = __builtin_bit_cast(v4i_t, b0), x1 = __builtin_bit_cast(v4i_t, b1), y0 = __builtin_bit_cast(v4i_t, a0), y1 = __builtin_bit_cast(v4i_t, a1);
    const v8i_t x = __builtin_shufflevector(x0, x1, 0, 1, 2, 3, 4, 5, 6, 7), y = __builtin_shufflevector(y0, y1, 0, 1, 2, 3, 4, 5, 6, 7);
    return __builtin_amdgcn_mfma_scale_f32_16x16x128_f8f6f4(x, y, c, 0, 0, 0, 0x7F7F7F7F, 0, 0x7F7F7F7F);
}

template <class Epi, class Sched, bool ALIGN_EPI = false, bool SP2 = false, int F8 = 0>
__device__ __forceinline__ void gemm_phase(PG8_LAS unsigned char* lds, const Gemm g, const Sched& S, const Epi& E) {
    const int tid = threadIdx.x, wid = __builtin_amdgcn_readfirstlane(tid >> 6), lane = tid & 63, wr = wid >> 2, wc = wid & 3, fr = lane & 15, fq = lane >> 4;
    const int K = g.K, nt = g.Kl / BK;
    unsigned voffA[2], voffB[2];
#pragma unroll
    for (int i = 0; i < 2; ++i) { int R, C; stage_rc(tid * 16 + i * 8192, R, C); const int Rb = Epi::PERM ? ((R & ~31) + perm32(R & 31)) : R;
        voffA[i] = (unsigned)(R * K + C) * 2u; voffB[i] = (unsigned)(Rb * K + C) * 2u; }
    const size_t kstep = (size_t)(BK * 2);
    const size_t hstep = (size_t)HALF * K * 2;
    const size_t tstep = 2 * hstep;
    const unsigned ldsw = (unsigned)wid * 1024u;
    const int aoff = lds_byte(wr * 64 + fr, fq * 8), boff = lds_byte(wc * 32 + fr, fq * 8);
#define PG8_SA(b, h) (((b) * 2 + (h)) * HTB)
#define PG8_SB(b, h) ((4 + (b) * 2 + (h)) * HTB)
#define PG8_STAGE(bufoff, gbase, voff) do { _Pragma("unroll") for (int _i = 0; _i < 2; ++_i) \
        __builtin_amdgcn_global_load_lds((const unsigned*)((const char*)(gbase) + (voff)[_i]), (PG8_LAS unsigned*)(lds + (bufoff) + ldsw + _i * 8192), 16, 0, 0); } while (0)
#define PG8_LDA(dst, b, h) do { if constexpr (F8 >= 2) { _Pragma("unroll") for (int m = 0; m < 4; ++m) { const v4i_t l0_ = *(const PG8_LAS v4i_t*)(lds + PG8_SA(b, h) + aoff + m * 2048); const v2i_t l1_ = *(const volatile PG8_LAS v2i_t*)(lds + PG8_SA(b, h) + aoff + m * 2048 + 1024 + o6_); dst##6[m] = (v6i_t){l0_.x, l0_.y, l0_.z, l0_.w, l1_.x, l1_.y}; } } \
        else if constexpr (F8 == 1) { _Pragma("unroll") for (int m = 0; m < 4; ++m) { const v4i_t l0_ = *(const PG8_LAS v4i_t*)(lds + PG8_SA(b, h) + aoff + m * 2048), l1_ = *(const PG8_LAS v4i_t*)(lds + PG8_SA(b, h) + aoff + m * 2048 + 1024); dst##8[m] = __builtin_shufflevector(l0_, l1_, 0, 1, 2, 3, 4, 5, 6, 7); } } \
        else { _Pragma("unroll") for (int m = 0; m < 4; ++m) _Pragma("unroll") for (int k = 0; k < 2; ++k) dst[m][k] = *(const PG8_LAS bf16x8*)(lds + PG8_SA(b, h) + aoff + m * 2048 + k * 1024); } } while (0)
#define PG8_LDB(dst, b, h) do { if constexpr (F8 >= 2) { _Pragma("unroll") for (int n = 0; n < 2; ++n) { const v4i_t l0_ = *(const PG8_LAS v4i_t*)(lds + PG8_SB(b, h) + boff + n * 2048); const v2i_t l1_ = *(const volatile PG8_LAS v2i_t*)(lds + PG8_SB(b, h) + boff + n * 2048 + 1024 + o6b_); dst##6[n] = (v6i_t){l0_.x, l0_.y, l0_.z, l0_.w, l1_.x, l1_.y}; } } \
        else if constexpr (F8 == 1) { _Pragma("unroll") for (int n = 0; n < 2; ++n) { const v4i_t l0_ = *(const PG8_LAS v4i_t*)(lds + PG8_SB(b, h) + boff + n * 2048), l1_ = *(const PG8_LAS v4i_t*)(lds + PG8_SB(b, h) + boff + n * 2048 + 1024); dst##8[n] = __builtin_shufflevector(l0_, l1_, 0, 1, 2, 3, 4, 5, 6, 7); } } \
        else { _Pragma("unroll") for (int n = 0; n < 2; ++n) _Pragma("unroll") for (int k = 0; k < 2; ++k) dst[n][k] = *(const PG8_LAS bf16x8*)(lds + PG8_SB(b, h) + boff + n * 2048 + k * 1024); } } while (0)
#define PG8_MMA(ai, bj, At, Bt) do { __builtin_amdgcn_s_setprio(1); _Pragma("unroll") for (int m = 0; m < 4; ++m) _Pragma("unroll") for (int n = 0; n < 2; ++n) { \
        if constexpr (F8 == 3) asm volatile("v_mfma_scale_f32_16x16x128_f8f6f4 %0, %1, %2, %0, %3, %3 op_sel_hi:[0,0,0] cbsz:2 blgp:3" : "+v"(acc[ai][bj][m][n]) : "v"(Bt##6[n]), "v"(At##6[m]), "v"(sc8_)); \
        else if constexpr (F8 == 2) asm volatile("v_mfma_scale_f32_16x16x128_f8f6f4 %0, %1, %2, %0, %3, %3 op_sel_hi:[0,0,0] cbsz:2 blgp:2" : "+v"(acc[ai][bj][m][n]) : "v"(Bt##6[n]), "v"(At##6[m]), "v"(sc8_)); \
        else if constexpr (F8 == 1) asm volatile("v_mfma_scale_f32_16x16x128_f8f6f4 %0, %1, %2, %0, %3, %3 op_sel_hi:[0,0,0]" : "+v"(acc[ai][bj][m][n]) : "v"(Bt##8[n]), "v"(At##8[m]), "v"(sc8_)); \
        else { _Pragma("unroll") for (int k = 0; k < 2; ++k) acc[ai][bj][m][n] = __builtin_amdgcn_mfma_f32_16x16x32_bf16(Bt[n][k], At[m][k], acc[ai][bj][m][n], 0, 0, 0); } } __builtin_amdgcn_s_setprio(0); } while (0)
#define PG8_WAIT_V(n) asm volatile("s_waitcnt vmcnt(" #n ")" ::: "memory")
#define PG8_WAIT_L(n) asm volatile("s_waitcnt lgkmcnt(" #n ")" ::: "memory")
#define PG8_BAR __builtin_amdgcn_s_barrier()
#define PG8_SCHED __builtin_amdgcn_sched_barrier(0)
    Unit cur, nxt; int ui = 0;
    if (!S.next(0, cur)) return;
    f32x4 acc[2][2][4][2];
#pragma unroll
    for (int a = 0; a < 2; ++a)
#pragma unroll
        for (int b = 0; b < 2; ++b)
#pragma unroll
            for (int m = 0; m < 4; ++m)
#pragma unroll
                for (int n = 0; n < 2; ++n) acc[a][b][m][n] = (f32x4){0.f, 0.f, 0.f, 0.f};
    bf16x8 At[4][2], B0[2][2], B1[2][2]; v8i_t At8[4], B08[2], B18[2]; v6i_t At6[4], B06[2], B16[2]; const int o6_ = ((fr >> 2) & 1) * 8, o6b_ = Epi::PERM ? o6_ : ((fr >> 3) & 1) * 8;     const int sc8_ = 0x7F7F7F7F;
    const char* cA = (const char*)g.A + (size_t)cur.pm * tstep + (size_t)cur.ko * 2; const char* cB = (const char*)g.Bt + (size_t)cur.pb * tstep + (size_t)cur.ko * 2;
    S.a_ready(cur);
    if constexpr (SP2) {
        PG8_STAGE(PG8_SB(0, 0), cB, voffB); PG8_STAGE(PG8_SB(0, 1), cB + hstep, voffB); PG8_STAGE(PG8_SA(0, 0), cA, voffA); PG8_STAGE(PG8_SA(0, 1), cA + hstep, voffA);
        if (wr == 1) PG8_BAR;
        PG8_WAIT_V(2); PG8_BAR;
        PG8_STAGE(PG8_SB(1, 0), cB + kstep, voffB); PG8_STAGE(PG8_SA(1, 0), cA + kstep, voffA); PG8_STAGE(PG8_SB(1, 1), cB + hstep + kstep, voffB);
        PG8_WAIT_V(6); PG8_BAR;
    } else {
        PG8_STAGE(PG8_SB(0, 0), cB, voffB); PG8_STAGE(PG8_SA(0, 0), cA, voffA); PG8_STAGE(PG8_SB(0, 1), cB + hstep, voffB); PG8_STAGE(PG8_SA(0, 1), cA + hstep, voffA);
        if (wr == 1) PG8_BAR;
        PG8_WAIT_V(4); PG8_BAR;
        PG8_STAGE(PG8_SB(1, 0), cB + kstep, voffB); PG8_STAGE(PG8_SA(1, 0), cA + kstep, voffA); PG8_STAGE(PG8_SB(1, 1), cB + hstep + kstep, voffB);
        PG8_WAIT_V(6); PG8_BAR;
    }
    for (;;) {
        const bool has_next = S.next(ui + 1, nxt);
        const char* nA = has_next ? (const char*)g.A + (size_t)nxt.pm * tstep + (size_t)nxt.ko * 2 : cA; const char* nB = has_next ? (const char*)g.Bt + (size_t)nxt.pb * tstep + (size_t)nxt.ko * 2 : cB;
        for (int t = 0; t < nt; t += 2) {
            const bool last = (t == nt - 2);
            const char* a1 = cA + (size_t)(t + 1) * kstep;
            const char* a2 = last ? nA : cA + (size_t)(t + 2) * kstep; const char* b2 = last ? nB : cB + (size_t)(t + 2) * kstep;
            const char* a3 = a2 + kstep; const char* b3 = b2 + kstep;
            if (last && has_next) S.a_ready(nxt);
            if constexpr (SP2) {
            PG8_LDB(B0, 0, 0); PG8_LDB(B1, 0, 1); PG8_SCHED; PG8_LDA(At, 0, 0); PG8_STAGE(PG8_SA(1, 1), a1 + hstep, voffA);
            PG8_WAIT_V(8); PG8_WAIT_L(0); PG8_BAR; PG8_MMA(0, 0, At, B0); PG8_MMA(0, 1, At, B1); PG8_BAR; PG8_SCHED;
            PG8_LDA(At, 0, 1); PG8_STAGE(PG8_SB(0, 0), b2, voffB); PG8_STAGE(PG8_SB(0, 1), b2 + hstep, voffB); PG8_STAGE(PG8_SA(0, 0), a2, voffA);
            PG8_WAIT_V(8); PG8_WAIT_L(0); PG8_BAR; PG8_MMA(1, 0, At, B0); PG8_MMA(1, 1, At, B1); PG8_BAR; PG8_SCHED;
            PG8_LDB(B0, 1, 0); PG8_LDB(B1, 1, 1); PG8_SCHED; PG8_LDA(At, 1, 0); PG8_STAGE(PG8_SA(0, 1), a2 + hstep, voffA);
            PG8_WAIT_V(8); PG8_WAIT_L(0); PG8_BAR; PG8_MMA(0, 0, At, B0); PG8_MMA(0, 1, At, B1); PG8_BAR; PG8_SCHED;
            PG8_LDA(At, 1, 1); PG8_STAGE(PG8_SB(1, 0), b3, voffB); PG8_STAGE(PG8_SB(1, 1), b3 + hstep, voffB); PG8_STAGE(PG8_SA(1, 0), a3, voffA);
            PG8_WAIT_V(8); PG8_WAIT_L(0); PG8_BAR; PG8_MMA(1, 0, At, B0); PG8_MMA(1, 1, At, B1); PG8_BAR; PG8_SCHED;
            } else {
            PG8_LDB(B0, 0, 0); PG8_SCHED; PG8_LDA(At, 0, 0); PG8_STAGE(PG8_SA(1, 1), a1 + hstep, voffA);
            PG8_WAIT_L(8); PG8_BAR; PG8_WAIT_L(0); PG8_MMA(0, 0, At, B0); PG8_BAR; PG8_SCHED;
            PG8_LDB(B1, 0, 1); PG8_STAGE(PG8_SB(0, 0), b2, voffB);
            PG8_BAR; PG8_WAIT_L(0); PG8_MMA(0, 1, At, B1); PG8_BAR;
            PG8_LDA(At, 0, 1); PG8_STAGE(PG8_SA(0, 0), a2, voffA);
            PG8_BAR; PG8_WAIT_L(0); PG8_MMA(1, 0, At, B0); PG8_BAR; PG8_SCHED;
            PG8_STAGE(PG8_SB(0, 1), b2 + hstep, voffB);
            PG8_WAIT_V(6); PG8_BAR; PG8_MMA(1, 1, At, B1); PG8_BAR;
            PG8_LDB(B0, 1, 0); PG8_SCHED; PG8_LDA(At, 1, 0); PG8_STAGE(PG8_SA(0, 1), a2 + hstep, voffA);
            PG8_WAIT_L(8); PG8_BAR; PG8_WAIT_L(0); PG8_MMA(0, 0, At, B0); PG8_BAR; PG8_SCHED;
            PG8_LDB(B1, 1, 1); PG8_STAGE(PG8_SB(1, 0), b3, voffB);
            PG8_BAR; PG8_WAIT_L(0); PG8_MMA(0, 1, At, B1); PG8_BAR;
            PG8_LDA(At, 1, 1); PG8_STAGE(PG8_SA(1, 0), a3, voffA);
            PG8_BAR; PG8_WAIT_L(0); PG8_MMA(1, 0, At, B0); PG8_BAR; PG8_SCHED;
            PG8_STAGE(PG8_SB(1, 1), b3 + hstep, voffB);
            PG8_WAIT_V(6); PG8_BAR; PG8_MMA(1, 1, At, B1); PG8_BAR;
            }
        }
        if constexpr (ALIGN_EPI) { if (wr == 0) PG8_BAR; }
        if constexpr (F8) asm volatile("s_nop 15\n\ts_nop 15" ::: "memory");
        if constexpr (!Epi::AFTER_DRAIN) { E(acc, cur, wr, wc, fr, fq); S.done(cur); }
        if (!has_next) break;
#pragma unroll
        for (int a = 0; a < 2; ++a)
#pragma unroll
            for (int b = 0; b < 2; ++b)
#pragma unroll
                for (int m = 0; m < 4; ++m)
#pragma unroll
                    for (int n = 0; n < 2; ++n) acc[a][b][m][n] = (f32x4){0.f, 0.f, 0.f, 0.f};
        cur = nxt; cA = nA; cB = nB; ++ui;
        if constexpr (ALIGN_EPI) { if (wr == 1) PG8_BAR; }
    }
    PG8_WAIT_V(0);
    if constexpr (!ALIGN_EPI) { if (wr == 0) PG8_BAR; }
    PG8_BAR;
    if constexpr (Epi::AFTER_DRAIN) { E.fused(acc, cur, wr, wc, fr, fq, lds, wid, lane); S.done(cur); }
#undef PG8_SA
#undef PG8_SB
#undef PG8_STAGE
#undef PG8_LDA
#undef PG8_LDB
#undef PG8_MMA
#undef PG8_WAIT_V
#undef PG8_WAIT_L
#undef PG8_BAR
#undef PG8_SCHED
}

template <class Epi, class Sched>
__device__ __forceinline__ void gemm_phase_simple(const Gemm g, const Sched& S, const Epi& E) {
    const int tid = threadIdx.x, wid = __builtin_amdgcn_readfirstlane(tid >> 6), lane = tid & 63, wr = wid >> 2, wc = wid & 3, fr = lane & 15, fq = lane >> 4;
    const int K = g.K; Unit u;
    for (int i = 0; S.next(i, u); ++i) {
        f32x4 acc[2][2][4][2];
#pragma unroll
        for (int a = 0; a < 2; ++a)
#pragma unroll
            for (int b = 0; b < 2; ++b)
#pragma unroll
                for (int m = 0; m < 4; ++m)
#pragma unroll
                    for (int n = 0; n < 2; ++n) acc[a][b][m][n] = (f32x4){0.f, 0.f, 0.f, 0.f};
        const bf16_t* Ab = g.A + (size_t)u.pm * BM * K + u.ko; const bf16_t* Bb = g.Bt + (size_t)u.pb * BM * K + u.ko;
        for (int k0 = 0; k0 < g.Kl; k0 += 32) {
            bf16x8 a[2][4], b[2][2];
#pragma unroll
            for (int ai = 0; ai < 2; ++ai)
#pragma unroll
                for (int m = 0; m < 4; ++m) a[ai][m] = *(const bf16x8*)(Ab + (size_t)(ai * HALF + wr * 64 + m * 16 + fr) * K + k0 + fq * 8);
#pragma unroll
            for (int bj = 0; bj < 2; ++bj)
#pragma unroll
                for (int n = 0; n < 2; ++n) { const int rl = 16 * n + fr, rr = Epi::PERM ? perm32(rl) : rl; b[bj][n] = *(const bf16x8*)(Bb + (size_t)(bj * HALF + wc * 32 + rr) * K + k0 + fq * 8); }
#pragma unroll
            for (int ai = 0; ai < 2; ++ai)
#pragma unroll
                for (int bj = 0; bj < 2; ++bj)
#pragma unroll
                    for (int m = 0; m < 4; ++m)
#pragma unroll
                        for (int n = 0; n < 2; ++n) acc[ai][bj][m][n] = __builtin_amdgcn_mfma_f32_16x16x32_bf16(b[bj][n], a[ai][m], acc[ai][bj][m][n], 0, 0, 0);
        }
        E(acc, u, wr, wc, fr, fq);
    }
}
}

constexpr int NWAVES = 8;
constexpr int N_LAUNCHES = MK_N_LAUNCHES;
constexpr int N_PHASES = 17;
constexpr int M = 16384, D = 2048, SEQ = 2048, NQKV = 3072, NH = 16, NKV = 4, HD = 128;
constexpr int FF = 5632, GWD = 2048, NE = 8, FE = 7168;
constexpr int PMAX = 2 * M + NE * 256;
constexpr float EPS = 1e-6f;
constexpr float W8SCALE = 64.0f, A8SCALE = 4.0f, H8SCALE = 8.0f;
constexpr float W6SCALE = 80.0f, A6SCALE = 1.75f, W6SCALE_D = 150.0f, H6SCALE = 2.5f;

constexpr size_t MiB = 1u << 20, KiB = 1u << 10;
constexpr size_t WS_CTL = 0, CTL_ZERO_BYTES = 1 * MiB;
constexpr size_t WS_RSTD0 = 1 * MiB, WS_RSTD1 = WS_RSTD0 + 64 * KiB, WS_RSTD2 = WS_RSTD1 + 64 * KiB, WS_ROWW = WS_RSTD2 + 64 * KiB  , WS_TEXP = WS_ROWW + 192 * KiB;
constexpr size_t WS_ROUTE = 2 * MiB;
constexpr size_t WS_PART = 3 * MiB, WS_PARTV = 5 * MiB;
constexpr size_t WS_WQKV = 8 * MiB, WS_WO = 20 * MiB, WS_WGU = 28 * MiB, WS_WD = 72 * MiB, WS_WIN = 94 * MiB, WS_WOUT = 110 * MiB, WS_WEGU = 118 * MiB, WS_WED = 566 * MiB;
constexpr size_t WS_HB = 790 * MiB;
constexpr size_t WS_R = 854 * MiB;
constexpr size_t WS_QKV = WS_R, WS_AO = WS_R + 96 * MiB;
constexpr size_t WS_HFF = WS_R;
constexpr size_t WS_Z = WS_R, WS_Y = WS_R + 128 * MiB;
constexpr size_t WS_HS = WS_R, WS_HE = WS_R + 136 * MiB;
constexpr size_t WS_PTL = WS_R + 612 * MiB;
constexpr size_t WS_END = WS_PTL + 64 * MiB;
static_assert(WS_WO - WS_WQKV >= (size_t)NQKV * D * 2 && WS_WD - WS_WGU >= (size_t)2 * FF * D * 2 && WS_WIN - WS_WD >= (size_t)FF * D * 2 && WS_WED - WS_WEGU >= (size_t)NE * 2 * FE * D * 2 && WS_HB - WS_WED >= (size_t)NE * FE * D * 2, "weights map");
static_assert(WS_HE - WS_HS >= (size_t)PMAX * D * 2 && WS_END - WS_HE >= (size_t)PMAX * FE * 2 && WS_AO - WS_QKV >= (size_t)M * NQKV * 2 && (size_t)M * FF * 2 <= 612 * MiB && WS_Y - WS_Z >= (size_t)M * 2 * GWD * 2, "activation map");
constexpr int CW_TMO = 0, CW_NMT = 2, CW_BAR = 4096, CW_CNT = 8192;

constexpr int RING_OFF = 0, RING_BYTES = 131072;
constexpr int LDSCTL_OFF = RING_BYTES, MISC_OFF = LDSCTL_OFF + 320;
constexpr int TEXP_OFF = LDSCTL_OFF + 1024;
constexpr int LDS_BYTES = 147456;
static_assert(TEXP_OFF + 4 * 160 <= LDS_BYTES, "LDS map");

#define GAS __attribute__((address_space(1)))
#define LAS __attribute__((address_space(3)))
typedef unsigned short bf16;
typedef unsigned v4u __attribute__((ext_vector_type(4)));
typedef unsigned v2u __attribute__((ext_vector_type(2)));
typedef float f32x4 __attribute__((ext_vector_type(4)));
typedef short bf16x8 __attribute__((ext_vector_type(8)));
typedef GAS unsigned gu32;
#define RLX_AGENT __ATOMIC_RELAXED, __HIP_MEMORY_SCOPE_AGENT
#define LDS_WAIT() asm volatile("s_waitcnt lgkmcnt(0)" ::: "memory")
#define VM_WAIT() asm volatile("s_waitcnt vmcnt(0)" ::: "memory")
__device__ __forceinline__ unsigned f2bf(float f) { unsigned u = __builtin_bit_cast(unsigned, f); return (u + 0x7fffu + ((u >> 16) & 1u)) >> 16; }
__device__ __forceinline__ unsigned pk2(float lo, float hi) { return f2bf(lo) | (f2bf(hi) << 16); }
__device__ __forceinline__ float bf2f(unsigned short b) { return __uint_as_float((unsigned)b << 16); }
__device__ __forceinline__ float bflo(unsigned w) { return __uint_as_float(w << 16); }
__device__ __forceinline__ float bfhi(unsigned w) { return __uint_as_float(w & 0xffff0000u); }

#define XB_TMO      128
#define XB_XCNT(j)  (256  + 64 * (j))
#define XB_XSUB(j)  (1280 + 64 * (j))
#define XB_XGEN(j)  (2304 + 64 * (j))
#define XB_TOP      3328
#define XB_TOPGEN   3392
#define XCD_BAR_WORDS 3456
#define XB_SPIN_CAP (1u << 18)

__device__ __forceinline__ unsigned xb_ld(unsigned* p)              { return __hip_atomic_load(p, __ATOMIC_RELAXED, __HIP_MEMORY_SCOPE_AGENT); }
__device__ __forceinline__ unsigned xb_add(unsigned* p, unsigned v) { return __hip_atomic_fetch_add(p, v, __ATOMIC_RELAXED, __HIP_MEMORY_SCOPE_AGENT); }
__device__ __forceinline__ unsigned xb_xcc_id() { return (unsigned)__builtin_amdgcn_s_getreg((3 << 11) | 20) & 0xFu; }
#define XB_SPIN(cond, bar) do { unsigned _sp = 0; while (cond) { __builtin_amdgcn_s_sleep(1); \
    if ((++_sp & 255u) == 0u) { if (xb_ld(&(bar)[XB_TMO])) break; if (_sp > XB_SPIN_CAP) { atomicAdd(&(bar)[XB_TMO], 1u); break; } } } } while (0)

struct XcdBarrier {
    unsigned* bar; unsigned x;
    volatile LAS unsigned* st;
};

__device__ __forceinline__ XcdBarrier xcd_barrier_post(unsigned* bar, volatile LAS unsigned* st) {
    XcdBarrier b; b.bar = bar; b.x = xb_xcc_id(); b.st = st;
    if (threadIdx.x == 0) (void)xb_add(&bar[XB_XCNT(b.x)], 1u);
    return b;
}
__device__ __forceinline__ void xcd_barrier_complete(unsigned* bar, unsigned x, unsigned& nloc, unsigned& nx) {
    const unsigned G = gridDim.x * gridDim.y * gridDim.z;
    unsigned sum, cnt, mine, sp = 0u;
    for (;;) {
        sum = 0u; cnt = 0u; mine = 0u;
#pragma unroll
        for (unsigned j = 0; j < 16; ++j) { const unsigned c = xb_ld(&bar[XB_XCNT(j)]); sum += c; cnt += (c > 0u) ? 1u : 0u; mine = (j == x) ? c : mine; }
        if (sum == G) break;
        __builtin_amdgcn_s_sleep(1);
        if ((++sp & 255u) == 0u) { if (xb_ld(&bar[XB_TMO])) break; if (sp > XB_SPIN_CAP) { atomicAdd(&bar[XB_TMO], 1u); break; } }
    }
    nloc = mine > 0u ? mine : 1u; nx = cnt > 0u ? cnt : 1u;
}

__device__ __forceinline__ void xcd_barrier(const XcdBarrier& b) {
    asm volatile("s_waitcnt vmcnt(0)" ::: "memory");
    __syncthreads();
    if (threadIdx.x == 0) {
        unsigned* bar = b.bar;
        __builtin_amdgcn_s_waitcnt(0);
        unsigned nloc = b.st[0], nx = b.st[1];
        if (nloc == 0u) { xcd_barrier_complete(bar, b.x, nloc, nx); b.st[0] = nloc; b.st[1] = nx; }
        const unsigned old = xb_add(&bar[XB_XSUB(b.x)], 1u);
        const unsigned gen = old / nloc;
        if (old + 1u == (gen + 1u) * nloc) {
            __builtin_amdgcn_fence(__ATOMIC_RELEASE, "agent");
            asm volatile("s_waitcnt vmcnt(0)" ::: "memory");
            const unsigned og = xb_add(&bar[XB_TOP], 1u);
            const unsigned tg = og / nx;
            if (og + 1u == (tg + 1u) * nx) xb_add(&bar[XB_TOPGEN], 1u);
            else XB_SPIN(xb_ld(&bar[XB_TOPGEN]) == tg, bar);
            __builtin_amdgcn_fence(__ATOMIC_ACQUIRE, "agent");
            xb_add(&bar[XB_XGEN(b.x)], 1u);
            asm volatile("s_waitcnt vmcnt(0)" ::: "memory");
        } else {
            XB_SPIN(xb_ld(&bar[XB_XGEN(b.x)]) == gen, bar);
            __builtin_amdgcn_fence(__ATOMIC_ACQUIRE, "agent");
            asm volatile("s_waitcnt vmcnt(0)" ::: "memory");
        }
    }
    __syncthreads();
}

__device__ __forceinline__ float wave_sum(float v) {
#pragma unroll
    for (int o = 1; o < 64; o <<= 1) v += __shfl_xor(v, o);
    return v;
}

__device__ __forceinline__ unsigned cvt4_fp8(float a, float b, float c, float d) { int r = __builtin_amdgcn_cvt_pk_fp8_f32(a, b, 0, false); r = __builtin_amdgcn_cvt_pk_fp8_f32(c, d, r, true); return (unsigned)r; }
struct MoeDesc { const float* src; unsigned char* dst; int ldw, K, k0, n0, mode; };
constexpr int MOE_IE = 32 * 112;
constexpr int NMOE = 3 * NE * MOE_IE;
__device__ __forceinline__ void moe_desc(int r, const float* wg, const float* wu, const float* wd, unsigned char* dgu, unsigned char* dd, MoeDesc& d) {
    const int sel = (r >= NE * MOE_IE ? 1 : 0) + (r >= 2 * NE * MOE_IE ? 1 : 0);
    const int rr = r - sel * NE * MOE_IE, e = rr / MOE_IE, ri = rr - e * MOE_IE;
    const int kb = (sel == 2) ? ri / 32 : ri / 112, nb = ri - kb * ((sel == 2) ? 32 : 112);
    d.ldw = (sel == 2) ? D : FE; d.K = (sel == 2) ? FE : D; d.mode = (sel == 2) ? 0 : sel + 1; d.k0 = 64 * kb; d.n0 = 64 * nb;
    const float* base = (sel == 0) ? wg : ((sel == 1) ? wu : wd);
    d.src = base + (size_t)e * D * FE + (size_t)d.k0 * d.ldw + d.n0;
    d.dst = (sel == 2) ? dd + (size_t)e * D * FE : dgu + (size_t)e * 2 * FE * D;
}
__device__ __forceinline__ void moe_load(const MoeDesc& d, f32x4 (&v)[16], int lane) {
    const float* p = d.src + (size_t)(16 * (lane & 3)) * d.ldw + (lane >> 2) * 4;
#pragma unroll
    for (int i = 0; i < 16; ++i) v[i] = __builtin_nontemporal_load((const f32x4*)(p + (size_t)i * d.ldw));
}
__device__ __forceinline__ void moe_store(const MoeDesc& d, const f32x4 (&v)[16], int lane) {
    const int kc = lane & 3, nq = lane >> 2;
#pragma unroll
    for (int j = 0; j < 4; ++j) { const int nn = d.n0 + 4 * nq + j; const int drow = (d.mode == 0) ? nn : ((nn >> 7) * 256 + (nn & 127) + (d.mode == 2 ? 128 : 0));
        v4u o;
        o.x = cvt4_fp8(v[0][j] * W8SCALE, v[1][j] * W8SCALE, v[2][j] * W8SCALE, v[3][j] * W8SCALE);     o.y = cvt4_fp8(v[4][j] * W8SCALE, v[5][j] * W8SCALE, v[6][j] * W8SCALE, v[7][j] * W8SCALE);
        o.z = cvt4_fp8(v[8][j] * W8SCALE, v[9][j] * W8SCALE, v[10][j] * W8SCALE, v[11][j] * W8SCALE); o.w = cvt4_fp8(v[12][j] * W8SCALE, v[13][j] * W8SCALE, v[14][j] * W8SCALE, v[15][j] * W8SCALE);
        __builtin_nontemporal_store(o, (GAS v4u*)(d.dst + (size_t)drow * d.K + d.k0 + 16 * kc)); }
}

typedef float f32x2 __attribute__((ext_vector_type(2)));
typedef float v16f_t __attribute__((ext_vector_type(16)));
typedef unsigned v6u_t __attribute__((ext_vector_type(6)));
constexpr int NMOE6 = 3 * NE * MOE_IE;
struct Moe6Desc { const float* src; unsigned char* dst; int ldw, K, k0, n0, mode; float sc; };
__device__ __forceinline__ void moe6_desc(int r, const float* wg, const float* wu, const float* wd, unsigned char* dgu, unsigned char* dd, Moe6Desc& d) {
    const int sel = (r >= NE * MOE_IE ? 1 : 0) + (r >= 2 * NE * MOE_IE ? 1 : 0);
    const int rr = r - sel * NE * MOE_IE, e = rr / MOE_IE, ri = rr - e * MOE_IE;
    const int nbn = (sel == 2) ? 64 : 224, kb = ri / nbn, nb = ri - kb * nbn;
    d.ldw = (sel == 2) ? D : FE; d.K = (sel == 2) ? FE : D; d.mode = (sel == 2) ? 0 : sel + 1; d.k0 = 128 * kb; d.n0 = 32 * nb; d.sc = (sel == 2) ? W6SCALE_D : W6SCALE;
    const float* base = (sel == 0) ? wg : ((sel == 1) ? wu : wd);
    d.src = base + (size_t)e * D * FE + (size_t)d.k0 * d.ldw + d.n0;
    d.dst = (sel == 2) ? dd + (size_t)e * D * FE : dgu + (size_t)e * 2 * FE * D;
}
__device__ __forceinline__ void moe6_load(const Moe6Desc& d, f32x4 (&v)[16], int lane) {
    const float* p = d.src + (size_t)(16 * (lane & 7)) * d.ldw + (lane >> 3) * 4;
#pragma unroll
    for (int i = 0; i < 16; ++i) v[i] = __builtin_nontemporal_load((const f32x4*)(p + (size_t)i * d.ldw));
}
__device__ __forceinline__ float clamp6(float x) { return __builtin_amdgcn_fmed3f(x, -7.5f, 7.5f); }
__device__ __forceinline__ float swap1(float x) { return __int_as_float(__builtin_amdgcn_update_dpp(0, __float_as_int(x), 0xB1  , 0xF, 0xF, true)); }
__device__ __forceinline__ void moe6_store(const Moe6Desc& d, const f32x4 (&v)[16], int lane) {
    const int kc = lane & 7, nq = lane >> 3; const bool odd = lane & 1;
#pragma unroll
    for (int j = 0; j < 2; ++j) { const int nn = d.n0 + 4 * nq + (odd ? 2 : 0) + j; const int drow = (d.mode == 0) ? nn : ((nn >> 7) * 256 + (nn & 127) + (d.mode == 2 ? 128 : 0));
        v16f_t a, b;
#pragma unroll
        for (int i = 0; i < 16; ++i) { const float keep = odd ? v[i][2 + j] : v[i][j], send = odd ? v[i][j] : v[i][2 + j], recv = swap1(send);
            a[i] = clamp6((odd ? recv : keep) * d.sc); b[i] = clamp6((odd ? keep : recv) * d.sc); }
        const v6u_t r = __builtin_amdgcn_cvt_scalef32_2xpk16_fp6_f32(a, b, 1.0f);
        unsigned char* q = d.dst + (size_t)drow * d.K + d.k0 + 16 * (kc >> 1);
        const bool hi6 = (drow >> 3) & 1;
        v4u o0, o1; o0.x = r[0]; o0.y = r[1]; o0.z = r[2]; o0.w = r[3]; o1.x = hi6 ? 0u : r[4]; o1.y = hi6 ? 0u : r[5]; o1.z = hi6 ? r[4] : 0u; o1.w = hi6 ? r[5] : 0u;
        __builtin_nontemporal_store(o0, (GAS v4u*)q); __builtin_nontemporal_store(o1, (GAS v4u*)(q + 64)); }
}

typedef float f32x16 __attribute__((ext_vector_type(16)));
typedef short s16x4 __attribute__((ext_vector_type(4)));
typedef short v4i16_t __attribute__((ext_vector_type(4)));
typedef float f32x2_t __attribute__((ext_vector_type(2)));
typedef __bf16 bf16x2_t __attribute__((ext_vector_type(2)));
__device__ __forceinline__ unsigned cvtpk(float lo, float hi) { f32x2_t v = {lo, hi}; bf16x2_t b = __builtin_convertvector(v, bf16x2_t); return __builtin_bit_cast(unsigned, b); }
__device__ __forceinline__ s16x4 tr_read(const LAS unsigned char* p) { return __builtin_bit_cast(s16x4, __builtin_amdgcn_ds_read_tr16_b64_v4i16((LAS v4i16_t*)p)); }
__device__ __forceinline__ int crow(int i, int h) { return (i & 3) + 8 * (i >> 2) + 4 * h; }
#define MFMA32(a, b, c) __builtin_amdgcn_mfma_f32_32x32x16_bf16((a), (b), (c), 0, 0, 0)
constexpr int AT_STRIDE = 272;
constexpr int AT_VSTRIDE = 320;
constexpr int AT_K = 0, AT_V = 128 * AT_STRIDE, AT_END = AT_V + 128 * AT_VSTRIDE;

struct DenseDesc { const float* src; const float* gain; bf16* dst; int ldw, K, k0, n0, mode, hg; };
constexpr int DN0 = 32 * 48, DN1 = 32 * 32, DN2 = 32 * 88, DN3 = DN2, DN4 = 88 * 32, DN5 = 32 * 64, DN6 = 32 * 32;
constexpr int DB1 = DN0, DB2 = DB1 + DN1, DB3 = DB2 + DN2, DB4 = DB3 + DN3, DB5 = DB4 + DN4, DB6 = DB5 + DN5, NDENSE2 = DB6 + DN6;
struct DensePtrs { const float *wqkv, *wo, *wgu, *wd, *win, *wout, *g0, *g1, *g2; bf16 *dqkv, *dwo, *dgu, *dd, *din, *dout; };
__device__ __forceinline__ void dense_desc(int r, const DensePtrs& P, DenseDesc& d) {
    int ri, nblk; const float* w; const float* g; bf16* dst; int ldw, K = D, mode = 0, hg = 0, coff = 0;
    if (r < DB1)      { ri = r;       nblk = 48; w = P.wqkv; g = P.g0; hg = 1; dst = P.dqkv; ldw = NQKV; }
    else if (r < DB2) { ri = r - DB1; nblk = 32; w = P.wo;   g = P.g0;         dst = P.dwo;  ldw = D; }
    else if (r < DB3) { ri = r - DB2; nblk = 88; w = P.wgu;  g = P.g1; hg = 1; dst = P.dgu;  ldw = 2 * FF; mode = 1; }
    else if (r < DB4) { ri = r - DB3; nblk = 88; w = P.wgu;  g = P.g1; hg = 1; dst = P.dgu;  ldw = 2 * FF; mode = 2; coff = FF; }
    else if (r < DB5) { ri = r - DB4; nblk = 32; w = P.wd;   g = P.g0;         dst = P.dd;   ldw = D; K = FF; }
    else if (r < DB6) { ri = r - DB5; nblk = 64; w = P.win;  g = P.g2; hg = 1; dst = P.din;  ldw = 2 * GWD; }
    else              { ri = r - DB6; nblk = 32; w = P.wout; g = P.g0;         dst = P.dout; ldw = D; }
    const int kb = ri / nblk, nb = ri - kb * nblk;
    d.ldw = ldw; d.K = K; d.mode = mode; d.hg = hg; d.k0 = 64 * kb; d.n0 = 64 * nb;
    d.src = w + (size_t)d.k0 * ldw + coff + d.n0;
    d.gain = g + (hg ? d.k0 : 0);
    d.dst = dst;
}
__device__ __forceinline__ void dense_load(const DenseDesc& d, f32x4 (&v)[16], f32x4 (&gv)[4], int lane) {
    const float* gp = d.gain + 16 * (lane & 3);
#pragma unroll
    for (int q = 0; q < 4; ++q) { const f32x4 gl = *(const f32x4*)(gp + 4 * q); gv[q] = d.hg ? gl : (f32x4){1.f, 1.f, 1.f, 1.f}; }
    const float* p = d.src + (size_t)(16 * (lane & 3)) * d.ldw + (lane >> 2) * 4;
#pragma unroll
    for (int i = 0; i < 16; ++i) v[i] = __builtin_nontemporal_load((const f32x4*)(p + (size_t)i * d.ldw));
}
__device__ __forceinline__ void dense_store(const DenseDesc& d, const f32x4 (&v)[16], const f32x4 (&gv)[4], int lane) {
    const int kc = lane & 3, nq = lane >> 2;
#pragma unroll
    for (int j = 0; j < 4; ++j) { const int nn = d.n0 + 4 * nq + j; const int drow = (d.mode == 0) ? nn : ((nn >> 7) * 256 + (nn & 127) + (d.mode == 2 ? 128 : 0));
        v4u o0, o1;
        o0.x = cvtpk(v[0][j] * gv[0][0], v[1][j] * gv[0][1]);   o0.y = cvtpk(v[2][j] * gv[0][2], v[3][j] * gv[0][3]);   o0.z = cvtpk(v[4][j] * gv[1][0], v[5][j] * gv[1][1]);   o0.w = cvtpk(v[6][j] * gv[1][2], v[7][j] * gv[1][3]);
        o1.x = cvtpk(v[8][j] * gv[2][0], v[9][j] * gv[2][1]);   o1.y = cvtpk(v[10][j] * gv[2][2], v[11][j] * gv[2][3]); o1.z = cvtpk(v[12][j] * gv[3][0], v[13][j] * gv[3][1]); o1.w = cvtpk(v[14][j] * gv[3][2], v[15][j] * gv[3][3]);
        GAS v4u* q = (GAS v4u*)(d.dst + (size_t)drow * d.K + d.k0 + 16 * kc); q[0] = o0; q[1] = o1; }
}

__device__ __forceinline__ void attn_phase(LAS unsigned char* lds, const bf16* QKV, bf16* AO, const float* qn, const float* kn, const float* sink, int bid, int G, int tid) {
    const int lane = tid & 63, wid = __builtin_amdgcn_readfirstlane(tid >> 6), r = lane & 31, h = lane >> 5;
    const int q4 = (lane & 15) >> 2, p4 = lane & 3, blk = (lane >> 4) & 1;
    const int ch = tid & 15, srow = tid >> 4;
    const float L2E = 1.4426950408889634f, SC = 0.08838834764831845f * L2E;
    for (int u = bid; u < 1024; u += G) {
        const int qhalf = u & 1, kvh = (u >> 1) & 3, nb = (u >> 3) & 15, b = u >> 7;
        const int hq = kvh * 4 + (wid >> 1);
        const int tw = nb * 128 + qhalf * 64 + (wid & 1) * 32, t = tw + r;
        const int jb0 = nb > 0 ? nb - 1 : 0, jb1 = nb < 15 ? nb + 1 : 15;
        v4u kreg[4], vreg[4];
#define AT_ISSUE(jb_) do { _Pragma("unroll") for (int i = 0; i < 4; ++i) { const bf16* kp_ = QKV + (size_t)(b * SEQ + (jb_) * 128 + srow + 32 * i) * NQKV + NH * HD + kvh * HD + ch * 8; \
            kreg[i] = *(const v4u*)kp_; vreg[i] = *(const v4u*)(kp_ + NKV * HD); } } while (0)
        AT_ISSUE(jb0);
        bf16x8 qf[8];
        {
            const bf16* qp = QKV + (size_t)(b * SEQ + t) * NQKV + hq * HD + 8 * h;
            v4u raw[8]; float ssq = 0.f;
#pragma unroll
            for (int ks = 0; ks < 8; ++ks) { raw[ks] = *(const v4u*)(qp + 16 * ks);
                const float a0 = bflo(raw[ks].x), a1 = bfhi(raw[ks].x), a2 = bflo(raw[ks].y), a3 = bfhi(raw[ks].y), a4 = bflo(raw[ks].z), a5 = bfhi(raw[ks].z), a6 = bflo(raw[ks].w), a7 = bfhi(raw[ks].w);
                ssq += (a0 * a0 + a1 * a1) + (a2 * a2 + a3 * a3) + (a4 * a4 + a5 * a5) + (a6 * a6 + a7 * a7); }
            ssq += __shfl_xor(ssq, 32);
            const float rq = SC / sqrtf(ssq * (1.0f / HD) + EPS);
#pragma unroll
            for (int ks = 0; ks < 8; ++ks) { const int d0 = 16 * ks + 8 * h;
                const f32x4 g0 = *(const f32x4*)(qn + d0), g1 = *(const f32x4*)(qn + d0 + 4), k0 = *(const f32x4*)(kn + d0), k1 = *(const f32x4*)(kn + d0 + 4);
                v4u w;
                w.x = cvtpk(bflo(raw[ks].x) * rq * g0.x * k0.x, bfhi(raw[ks].x) * rq * g0.y * k0.y); w.y = cvtpk(bflo(raw[ks].y) * rq * g0.z * k0.z, bfhi(raw[ks].y) * rq * g0.w * k0.w);
                w.z = cvtpk(bflo(raw[ks].z) * rq * g1.x * k1.x, bfhi(raw[ks].z) * rq * g1.y * k1.y); w.w = cvtpk(bflo(raw[ks].w) * rq * g1.z * k1.z, bfhi(raw[ks].w) * rq * g1.w * k1.w);
                qf[ks] = __builtin_bit_cast(bf16x8, w); }
        }
        float m_run = -5e29f, l_run = 0.f;
        f32x16 o[4];
#pragma unroll
        for (int dt = 0; dt < 4; ++dt)
#pragma unroll
            for (int i = 0; i < 16; ++i) o[dt][i] = 0.f;
        const float nslope = -__builtin_amdgcn_exp2f(-0.5f * (float)(hq + 1)) * L2E, sinkl = sink[hq] * L2E;
        for (int jb = jb0; jb <= jb1; ++jb) {
            if (jb != jb0) __syncthreads();
#pragma unroll
            for (int i = 0; i < 4; ++i) { const int row = srow + 32 * i; const v4u kw = kreg[i];
                const float a0 = bflo(kw.x), a1 = bfhi(kw.x), a2 = bflo(kw.y), a3 = bfhi(kw.y), a4 = bflo(kw.z), a5 = bfhi(kw.z), a6 = bflo(kw.w), a7 = bfhi(kw.w);
                float ss = (a0 * a0 + a1 * a1) + (a2 * a2 + a3 * a3) + (a4 * a4 + a5 * a5) + (a6 * a6 + a7 * a7);
                ss += __shfl_xor(ss, 1); ss += __shfl_xor(ss, 2); ss += __shfl_xor(ss, 4); ss += __shfl_xor(ss, 8);
                const float rk = 1.0f / sqrtf(ss * (1.0f / HD) + EPS);
                v4u w; w.x = cvtpk(a0 * rk, a1 * rk); w.y = cvtpk(a2 * rk, a3 * rk); w.z = cvtpk(a4 * rk, a5 * rk); w.w = cvtpk(a6 * rk, a7 * rk);
                *(LAS v4u*)(lds + AT_K + row * AT_STRIDE + ch * 16) = w; *(LAS v4u*)(lds + AT_V + row * AT_VSTRIDE + ch * 16) = vreg[i]; }
            __syncthreads();
            if (jb < jb1) AT_ISSUE(jb + 1);
#pragma unroll
            for (int hf = 0; hf < 2; ++hf) {
                bool act[2], msk[2];
#pragma unroll
                for (int k2 = 0; k2 < 2; ++k2) { const int sb = jb * 128 + 64 * hf + 32 * k2, dlo = tw - sb - 31, dhi = tw + 31 - sb;
                    act[k2] = !(dlo > 128 || dhi < -128); msk[k2] = (dlo < -128 || dhi > 128); }
                if (!act[0] && !act[1]) continue;
                f32x16 s[2];
#pragma unroll
                for (int k2 = 0; k2 < 2; ++k2) if (act[k2]) {
#pragma unroll
                    for (int i = 0; i < 16; ++i) s[k2][i] = 0.f;
#pragma unroll
                    for (int ks = 0; ks < 8; ++ks) { const bf16x8 a = *(const LAS bf16x8*)(lds + AT_K + (64 * hf + 32 * k2 + r) * AT_STRIDE + (16 * ks + 8 * h) * 2); s[k2] = MFMA32(a, qf[ks], s[k2]); } }
                float bm = -1e30f;
#pragma unroll
                for (int k2 = 0; k2 < 2; ++k2) if (act[k2]) { const float d0 = (float)(t - (jb * 128 + 64 * hf + 32 * k2 + 4 * h));
#pragma unroll
                    for (int i = 0; i < 16; ++i) { const float x = d0 - (float)((i & 3) + 8 * (i >> 2)); float v = __builtin_fmaf(nslope, __builtin_fabsf(x), s[k2][i]);
                        if (msk[k2]) v = (__builtin_fabsf(x) <= 128.0f) ? v : -1e30f;
                        s[k2][i] = v; bm = fmaxf(bm, v); } }
                bm = fmaxf(bm, __shfl_xor(bm, 32));
                const float m_new = fmaxf(m_run, bm), alpha = __builtin_amdgcn_exp2f(m_run - m_new); m_run = m_new; l_run *= alpha;
#pragma unroll
                for (int dt = 0; dt < 4; ++dt)
#pragma unroll
                    for (int i = 0; i < 16; ++i) o[dt][i] *= alpha;
#pragma unroll
                for (int k2 = 0; k2 < 2; ++k2) if (act[k2]) {
                    float ps = 0.f;
#pragma unroll
                    for (int i = 0; i < 16; ++i) { const float p = __builtin_amdgcn_exp2f(s[k2][i] - m_new); s[k2][i] = p; ps += p; }
                    l_run += ps;
#pragma unroll
                    for (int s2 = 0; s2 < 2; ++s2) {
                        v4u pw; pw.x = cvtpk(s[k2][8 * s2 + 0], s[k2][8 * s2 + 1]); pw.y = cvtpk(s[k2][8 * s2 + 2], s[k2][8 * s2 + 3]); pw.z = cvtpk(s[k2][8 * s2 + 4], s[k2][8 * s2 + 5]); pw.w = cvtpk(s[k2][8 * s2 + 6], s[k2][8 * s2 + 7]);
                        const bf16x8 pf = __builtin_bit_cast(bf16x8, pw);
#pragma unroll
                        for (int dt = 0; dt < 4; ++dt) {
                            const LAS unsigned char* vp = lds + AT_V + (64 * hf + 32 * k2 + 16 * s2 + 4 * h + q4) * AT_VSTRIDE + (32 * dt + 16 * blk + 4 * p4) * 2;
                            const s16x4 lo = tr_read(vp), hi4 = tr_read(vp + 8 * AT_VSTRIDE);
                            const bf16x8 a = __builtin_shufflevector(lo, hi4, 0, 1, 2, 3, 4, 5, 6, 7);
                            o[dt] = MFMA32(a, pf, o[dt]); }
                    }
                }
            }
        }
#undef AT_ISSUE
        const float l_tot = l_run + __shfl_xor(l_run, 32);
        const float mf = fmaxf(m_run, sinkl), f = __builtin_amdgcn_exp2f(m_run - mf), sc = f / (l_tot * f + __builtin_amdgcn_exp2f(sinkl - mf));
        bf16* op = AO + (size_t)(b * SEQ + t) * D + hq * HD + 4 * h;
#pragma unroll
        for (int dt = 0; dt < 4; ++dt)
#pragma unroll
            for (int g4 = 0; g4 < 4; ++g4) { v2u w; w.x = cvtpk(o[dt][4 * g4] * sc, o[dt][4 * g4 + 1] * sc); w.y = cvtpk(o[dt][4 * g4 + 2] * sc, o[dt][4 * g4 + 3] * sc);
                *(v2u*)(op + 32 * dt + 8 * g4) = w; }
        __syncthreads();
    }
}

__device__ __forceinline__ void gating_phase(LAS unsigned char* lds, const bf16* Z, bf16* Y, const float* partv, const float* vnorm, const float* w_s, const float* b_s, int bid, int G, int tid) {
    const int lane = tid & 63, wid = __builtin_amdgcn_readfirstlane(tid >> 6), r = lane & 31, h = lane >> 5;
    const int q4 = (lane & 15) >> 2, p4 = lane & 3, blk = (lane >> 4) & 1;
    LAS float* rs = (LAS float*)(lds + 128 * AT_VSTRIDE);
    const int tt = wid >> 1, dt0 = 2 * (wid & 1);
    for (int u = bid; u < 8 * 16 * 16; u += G) {
        const int g = u & 15, c = (u >> 4) & 15, b = u >> 8, row0 = b * SEQ + c * 128;
        { const int ch = tid & 15;
#pragma unroll
          for (int i = 0; i < 4; ++i) { const int row = (tid >> 4) + 32 * i; const v4u w = *(const v4u*)(Z + (size_t)(row0 + row) * (2 * GWD) + GWD + g * 128 + ch * 8); *(LAS v4u*)(lds + row * AT_VSTRIDE + ch * 16) = w; } }
        if (tid < 128) { const f32x4* p = (const f32x4*)(partv + (size_t)(row0 + tid) * 32); float s = 0.f;
#pragma unroll
            for (int i = 0; i < 8; ++i) { const f32x4 v = p[i]; s += (v.x + v.y) + (v.z + v.w); }
            rs[tid] = 1.0f / sqrtf(s * (1.0f / GWD) + EPS); }
        __syncthreads();
        f32x16 acc[2];
#pragma unroll
        for (int dd = 0; dd < 2; ++dd)
#pragma unroll
            for (int i = 0; i < 16; ++i) acc[dd][i] = 0.f;
        const int t = 32 * tt + r;
        const float* wrow = w_s + (size_t)(g * 128 + t) * 128 + 8 * h;
#pragma unroll
        for (int ks = 0; ks < 8; ++ks) {
            const f32x4 w0 = *(const f32x4*)(wrow + 16 * ks), w1 = *(const f32x4*)(wrow + 16 * ks + 4);
            const f32x4 r0 = *(const LAS f32x4*)(rs + 16 * ks + 8 * h), r1 = *(const LAS f32x4*)(rs + 16 * ks + 8 * h + 4);
            v4u bw; bw.x = cvtpk(w0.x * r0.x, w0.y * r0.y); bw.y = cvtpk(w0.z * r0.z, w0.w * r0.w); bw.z = cvtpk(w1.x * r1.x, w1.y * r1.y); bw.w = cvtpk(w1.z * r1.z, w1.w * r1.w);
            const bf16x8 bfr = __builtin_bit_cast(bf16x8, bw);
#pragma unroll
            for (int dd = 0; dd < 2; ++dd) {
                const LAS unsigned char* vp = lds + (16 * ks + 8 * h + q4) * AT_VSTRIDE + (32 * (dt0 + dd) + 16 * blk + 4 * p4) * 2;
                const s16x4 lo = tr_read(vp), hi4 = tr_read(vp + 4 * AT_VSTRIDE);
                const bf16x8 a = __builtin_shufflevector(lo, hi4, 0, 1, 2, 3, 4, 5, 6, 7);
                acc[dd] = MFMA32(a, bfr, acc[dd]); }
        }
        const float bias = b_s[g * 128 + t];
        const bf16* up = Z + (size_t)(row0 + t) * (2 * GWD) + g * 128 + 4 * h; bf16* yp = Y + (size_t)(row0 + t) * GWD + g * 128 + 4 * h; const float* gvp = vnorm + g * 128 + 4 * h;
#pragma unroll
        for (int dd = 0; dd < 2; ++dd)
#pragma unroll
            for (int g4 = 0; g4 < 4; ++g4) { const int d = 32 * (dt0 + dd) + 8 * g4; const f32x4 gv = *(const f32x4*)(gvp + d); const v2u uw = *(const v2u*)(up + d);
                const float y0 = bflo(uw.x) * (acc[dd][4 * g4] * gv.x + bias), y1 = bfhi(uw.x) * (acc[dd][4 * g4 + 1] * gv.y + bias), y2 = bflo(uw.y) * (acc[dd][4 * g4 + 2] * gv.z + bias), y3 = bfhi(uw.y) * (acc[dd][4 * g4 + 3] * gv.w + bias);
                v2u w; w.x = cvtpk(y0, y1); w.y = cvtpk(y2, y3); *(v2u*)(yp + d) = w; }
        __syncthreads();
    }
}

struct Args { const float* in[21]; float* out; unsigned char* ws; int ph_lo, ph_hi; };

__global__ void __launch_bounds__(NWAVES * 64, 2) mega_fwd(Args args) {
    extern __shared__ __attribute__((aligned(16))) unsigned char lds_raw[];
    LAS unsigned char* lds = (LAS unsigned char*)lds_raw;
    volatile LAS unsigned* MISC = (volatile LAS unsigned*)(lds + MISC_OFF);
    const int tid = threadIdx.x, lane = tid & 63, wave = __builtin_amdgcn_readfirstlane(tid >> 6);
    const int G = gridDim.x, bid = blockIdx.x;
    const int gw = bid * NWAVES + wave, NGW = G * NWAVES;
    const int gt = bid * (NWAVES * 64) + tid, NGT = G * NWAVES * 64;
    unsigned char* ws = args.ws;
    gu32* ctl = (gu32*)(ws + WS_CTL);
    for (int u = tid; u < (LDS_BYTES - LDSCTL_OFF) / 4; u += NWAVES * 64) ((LAS unsigned*)(lds + LDSCTL_OFF))[u] = 0u;
    __syncthreads();
    XcdBarrier bar; bar.bar = (unsigned*)(ctl + CW_BAR); bar.x = 0; bar.st = nullptr;
    if (N_LAUNCHES == 1) bar = xcd_barrier_post((unsigned*)(ctl + CW_BAR), MISC + 8);
#define GRID_BAR() do { if (N_LAUNCHES == 1) xcd_barrier(bar); } while (0)
    const int lo = args.ph_lo, hi = args.ph_hi;
#ifdef DBG_REPEAT
    const int dbg_nrep = (args.ph_hi > 100) ? 1 : 2;
#endif
#ifdef DBG_ONLY
#define IN(k) ((k) == DBG_ONLY && lo <= (k) && (k) < hi)
#else
#define IN(k) (lo <= (k) && (k) < hi)
#endif
#define BOTH(k) (IN(k) && IN((k) + 1))
#ifdef DBG_REPEAT
#define REP(k) _Pragma("nounroll") for (int rep_ = 0; rep_ < (((k) == DBG_REPEAT) ? dbg_nrep : 1); ++rep_)
#else
#define REP(k)
#endif

    const float* x_in = args.in[0];
    float* xout = args.out;
    bf16* Wqkv_t = (bf16*)(ws + WS_WQKV); bf16* Wo_t = (bf16*)(ws + WS_WO); bf16* Wgu_t = (bf16*)(ws + WS_WGU); bf16* Wd_t = (bf16*)(ws + WS_WD);
    bf16* Win_t = (bf16*)(ws + WS_WIN); bf16* Wout_t = (bf16*)(ws + WS_WOUT); bf16* Wegu_t = (bf16*)(ws + WS_WEGU); bf16* Wed_t = (bf16*)(ws + WS_WED);
    bf16* HB = (bf16*)(ws + WS_HB); bf16* QKV = (bf16*)(ws + WS_QKV); bf16* AO = (bf16*)(ws + WS_AO); bf16* HFF = (bf16*)(ws + WS_HFF);
    bf16* Z = (bf16*)(ws + WS_Z); bf16* Y = (bf16*)(ws + WS_Y); bf16* HS = (bf16*)(ws + WS_HS); bf16* HE = (bf16*)(ws + WS_HE); bf16* YS = HS;
    float* rstd0 = (float*)(ws + WS_RSTD0); float* rstd1 = (float*)(ws + WS_RSTD1); float* rstd2 = (float*)(ws + WS_RSTD2);
    float* roww = (float*)(ws + WS_ROWW); int* texp_g = (int*)(ws + WS_TEXP);
    unsigned* route = (unsigned*)(ws + WS_ROUTE); float* part = (float*)(ws + WS_PART); float* partv = (float*)(ws + WS_PARTV);

#if USE_SIMPLE_GEMM
#define RUN_GEMM(EPI, SCHED, g, S, E) pg8::gemm_phase_simple<EPI, SCHED>(g, S, E)
#else
#define RUN_GEMM(EPI, SCHED, g, S, E) pg8::gemm_phase<EPI, SCHED, PG8_ALIGN_BF, true>(lds + RING_OFF, g, S, E)
#endif
#define RUN_GEMM_F8(EPI, SCHED, g, S, E) pg8::gemm_phase<EPI, SCHED, PG8_ALIGN_F8, true, 1>(lds + RING_OFF, g, S, E)
#define RUN_GEMM_F6(EPI, SCHED, g, S, E) pg8::gemm_phase<EPI, SCHED, PG8_ALIGN_F8, true, 2>(lds + RING_OFF, g, S, E)
#define RUN_GEMM_F6B(EPI, SCHED, g, S, E) pg8::gemm_phase<EPI, SCHED, PG8_ALIGN_F8, true, 3>(lds + RING_OFF, g, S, E)

    if (IN(0)) REP(0) {
        {
            DensePtrs P{args.in[2], args.in[6], args.in[8], args.in[9], args.in[11], args.in[15], args.in[1], args.in[7], args.in[10], Wqkv_t, Wo_t, Wgu_t, Wd_t, Win_t, Wout_t};
            DenseDesc d0, d1; f32x4 v0[16], v1[16], g0[4], g1[4];
            int it = gw;
#define DENSE_ISSUE(b, idx) do { const int ix0_ = (idx), ix_ = ix0_ < NDENSE2 ? ix0_ : NDENSE2 - 1; dense_desc(ix_, P, d##b); dense_load(d##b, v##b, g##b, lane); } while (0)
            DENSE_ISSUE(0, it);
            for (;;) {
                if (it >= NDENSE2) break; DENSE_ISSUE(1, it + NGW); dense_store(d0, v0, g0, lane); it += NGW;
                if (it >= NDENSE2) break; DENSE_ISSUE(0, it + NGW); dense_store(d1, v1, g1, lane); it += NGW;
            }
#undef DENSE_ISSUE
        }
        for (int m = gw; m < M; m += NGW) {
            const GAS f32x4* xr = (const GAS f32x4*)(x_in + (size_t)m * D) + lane;
            f32x4 v[8]; float s = 0.f;
#pragma unroll
            for (int j = 0; j < 8; ++j) { v[j] = xr[64 * j]; s += (v[j].x * v[j].x + v[j].y * v[j].y) + (v[j].z * v[j].z + v[j].w * v[j].w); }
            const float tot = wave_sum(s);
            if (lane == 0) rstd0[m] = 1.0f / sqrtf(tot * (1.0f / D) + EPS);
            GAS v2u* o8 = (GAS v2u*)(HB + (size_t)m * D) + lane;
#pragma unroll
            for (int j = 0; j < 8; ++j) { v2u w; w.x = pk2(v[j].x, v[j].y); w.y = pk2(v[j].z, v[j].w); o8[64 * j] = w; }
        }
        if (BOTH(0)) GRID_BAR();
    }

    if (IN(1)) REP(1) {
        pg8::Gemm g{HB, Wqkv_t, M, NQKV, D, D}; pg8::StaticOrder S; S.init(M, NQKV, G, bid);
        pg8::EpiRowScale E{QKV, NQKV, rstd0, 1.0f};
        RUN_GEMM(pg8::EpiRowScale, pg8::StaticOrder, g, S, E);
        if (BOTH(1)) GRID_BAR();
    }

    if (IN(2)) REP(2) {
        attn_phase(lds + RING_OFF, QKV, AO, args.in[3], args.in[4], args.in[5], bid, G, tid);
        if (BOTH(2)) GRID_BAR();
    }

    if (IN(3)) REP(3) {
        pg8::Gemm g{AO, Wo_t, M, D, D, D}; pg8::StaticOrder S; S.init(M, D, G, bid);
        typedef pg8::EpiRes<false, false, true, true> Epi3; Epi3 E{nullptr, HB, nullptr, HB, part, D};
        RUN_GEMM(Epi3, pg8::StaticOrder, g, S, E);
        if (BOTH(3)) GRID_BAR();
    }
    if (IN(4)) REP(4) {
        for (int r = gt; r < M; r += NGT) { const f32x4* p = (const f32x4*)(part + (size_t)r * 32); float s = 0.f;
#pragma unroll
            for (int i = 0; i < 8; ++i) { const f32x4 v = p[i]; s += (v.x + v.y) + (v.z + v.w); }
            rstd1[r] = 1.0f / sqrtf(s * (1.0f / D) + EPS); }
        if (BOTH(4)) GRID_BAR();
    }
    if (IN(5)) REP(5) {
        pg8::Gemm g{HB, Wgu_t, M, 2 * FF, D, D}; pg8::StaticOrder S; S.init(M, 2 * FF, G, bid);
        pg8::EpiSwiGLU<0> E{HFF, FF, rstd1, 1.0f};
        const int rounds5 = (S.nwg + G - 1) / G, slot5 = ((bid >> 3) + 4 * (bid & 7)) % (rounds5 + 1);
        S.i0 = 0; S.i1 = slot5;
        RUN_GEMM(pg8::EpiSwiGLU<0>, pg8::StaticOrder, g, S, E);
        {
            const float* wg_ = args.in[18]; const float* wu_ = args.in[19]; const float* wd_ = args.in[20]; unsigned char* dgu_ = (unsigned char*)Wegu_t; unsigned char* dd_ = (unsigned char*)Wed_t;
            {
#ifndef MOE6_RING
#define MOE6_RING 2
#endif
                Moe6Desc d0, d1; f32x4 v0[16], v1[16];
#if MOE6_RING == 3
                Moe6Desc d2; f32x4 v2[16];
#endif
                int it = gw;
#define MOE6_ISSUE(b, idx) do { const int ix0_ = (idx), ix_ = ix0_ < NMOE6 ? ix0_ : NMOE6 - 1; moe6_desc(ix_, wg_, wu_, wd_, dgu_, dd_, d##b); moe6_load(d##b, v##b, lane); } while (0)
#if MOE6_RING == 3
                MOE6_ISSUE(0, it); MOE6_ISSUE(1, it + NGW);
                for (;;) {
                    if (it >= NMOE6) break; MOE6_ISSUE(2, it + 2 * NGW); moe6_store(d0, v0, lane); it += NGW;
                    if (it >= NMOE6) break; MOE6_ISSUE(0, it + 2 * NGW); moe6_store(d1, v1, lane); it += NGW;
                    if (it >= NMOE6) break; MOE6_ISSUE(1, it + 2 * NGW); moe6_store(d2, v2, lane); it += NGW;
                }
#else
                MOE6_ISSUE(0, it);
                for (;;) {
                    if (it >= NMOE6) break; MOE6_ISSUE(1, it + NGW); moe6_store(d0, v0, lane); it += NGW;
                    if (it >= NMOE6) break; MOE6_ISSUE(0, it + NGW); moe6_store(d1, v1, lane); it += NGW;
                }
#endif
#undef MOE6_ISSUE
            }
        }
        S.i0 = slot5; S.i1 = 0x7fffffff;
        RUN_GEMM(pg8::EpiSwiGLU<0>, pg8::StaticOrder, g, S, E);
        if (BOTH(5)) GRID_BAR();
    }
    if (IN(6)) REP(6) {
        pg8::Gemm g{HFF, Wd_t, M, D, FF, FF}; pg8::StaticOrder S; S.init(M, D, G, bid);
        typedef pg8::EpiRes<false, false, true, true> Epi6; Epi6 E{nullptr, HB, nullptr, HB, part, D};
        RUN_GEMM(Epi6, pg8::StaticOrder, g, S, E);
        if (BOTH(6)) GRID_BAR();
    }
    if (IN(7)) REP(7) {
        for (int r = gt; r < M; r += NGT) { const f32x4* p = (const f32x4*)(part + (size_t)r * 32); float s = 0.f;
#pragma unroll
            for (int i = 0; i < 8; ++i) { const f32x4 v = p[i]; s += (v.x + v.y) + (v.z + v.w); }
            rstd2[r] = 1.0f / sqrtf(s * (1.0f / D) + EPS); }
        if (BOTH(7)) GRID_BAR();
    }
    if (IN(8)) REP(8) {
        pg8::Gemm g{HB, Win_t, M, 2 * GWD, D, D}; pg8::StaticOrder S; S.init(M, 2 * GWD, G, bid);
        pg8::EpiGelu E{Z, 2 * GWD, rstd2, partv, GWD / 256};
        RUN_GEMM(pg8::EpiGelu, pg8::StaticOrder, g, S, E);
        if (BOTH(8)) GRID_BAR();
    }
    if (IN(9)) REP(9) {
        gating_phase(lds + RING_OFF, Z, Y, partv, args.in[12], args.in[13], args.in[14], bid, G, tid);
        if (BOTH(9)) GRID_BAR();
    }
    if (IN(10)) REP(10) {
        pg8::Gemm g{Y, Wout_t, M, D, GWD, GWD}; pg8::StaticOrder S; S.init(M, D, G, bid);
        typedef pg8::EpiRes<false, true, false, false> Epi10; Epi10 E{nullptr, HB, xout, nullptr, nullptr, D};
        RUN_GEMM(Epi10, pg8::StaticOrder, g, S, E);
        if (BOTH(10)) GRID_BAR();
    }
    if (IN(11)) REP(11) {
        const float* g3 = args.in[16]; const float* wr_g = args.in[17];
        LAS float* wr = (LAS float*)(lds + RING_OFF);
        for (int i = tid; i < D * NE / 4; i += NWAVES * 64) ((LAS f32x4*)wr)[i] = ((const f32x4*)wr_g)[i];
        __syncthreads();
        for (int m = gw; m < M; m += NGW) {
            const GAS f32x4* xr = (const GAS f32x4*)(xout + (size_t)m * D) + lane;
            float s = 0.f;
#pragma unroll 1
            for (int j = 0; j < 8; ++j) { const f32x4 v = xr[64 * j]; s += (v.x * v.x + v.y * v.y) + (v.z * v.z + v.w * v.w); }
            const float rstd = 1.0f / sqrtf(wave_sum(s) * (1.0f / D) + EPS);
            float lg[NE];
#pragma unroll
            for (int e = 0; e < NE; ++e) lg[e] = 0.f;
            LAS unsigned char* hb = lds + RING_OFF + 65536 + wave * 8192;
#pragma unroll 1
            for (int j = 0; j < 8; ++j) { const f32x4 vv = xr[64 * j]; const f32x4 gg = ((const f32x4*)g3)[lane + 64 * j]; const f32x4 h = vv * rstd * gg;
                { f32x4 hs; hs.x = clamp6(h.x * A6SCALE); hs.y = clamp6(h.y * A6SCALE); hs.z = clamp6(h.z * A6SCALE); hs.w = clamp6(h.w * A6SCALE);
                  *(LAS f32x4*)(hb + 128 * ((lane >> 3) + 8 * j) + 16 * ((lane & 7) ^ ((lane >> 3) & 7))) = hs; }
                const int c0 = 4 * (lane + 64 * j);
#pragma unroll
                for (int i = 0; i < 4; ++i) { const f32x4 w0 = *(const LAS f32x4*)(wr + (c0 + i) * 8), w1 = *(const LAS f32x4*)(wr + (c0 + i) * 8 + 4); const float hv = h[i];
                    lg[0] += hv * w0.x; lg[1] += hv * w0.y; lg[2] += hv * w0.z; lg[3] += hv * w0.w; lg[4] += hv * w1.x; lg[5] += hv * w1.y; lg[6] += hv * w1.z; lg[7] += hv * w1.w; } }
            {
                __builtin_amdgcn_wave_barrier(); asm volatile("s_waitcnt lgkmcnt(0)" ::: "memory");
                v16f_t a6, b6;
#pragma unroll
                for (int c = 0; c < 4; ++c) { const f32x4 t0 = *(const LAS f32x4*)(hb + 128 * lane + 16 * (c ^ (lane & 7))), t1 = *(const LAS f32x4*)(hb + 128 * lane + 16 * ((c + 4) ^ (lane & 7)));
                    a6[4 * c] = t0.x; a6[4 * c + 1] = t0.y; a6[4 * c + 2] = t0.z; a6[4 * c + 3] = t0.w; b6[4 * c] = t1.x; b6[4 * c + 1] = t1.y; b6[4 * c + 2] = t1.z; b6[4 * c + 3] = t1.w; }
                const v6u_t r6 = __builtin_amdgcn_cvt_scalef32_2xpk16_fp6_f32(a6, b6, 1.0f);
                GAS unsigned char* o6 = (GAS unsigned char*)HB + (size_t)m * D + 128 * (lane >> 2) + 16 * (lane & 3);
                v4u o0, o1; o0.x = r6[0]; o0.y = r6[1]; o0.z = r6[2]; o0.w = r6[3]; o1.x = r6[4]; o1.y = r6[5]; o1.z = 0u; o1.w = 0u;
                *(GAS v4u*)o6 = o0; *(GAS v4u*)(o6 + 64) = o1;
                __builtin_amdgcn_wave_barrier(); asm volatile("" ::: "memory");
            }
#pragma unroll
            for (int e = 0; e < NE; ++e) lg[e] = wave_sum(lg[e]);
            int e0 = 0; float v0 = lg[0];
#pragma unroll
            for (int e = 1; e < NE; ++e) if (lg[e] > v0) { v0 = lg[e]; e0 = e; }
            int e1 = -1; float v1 = -3.0e38f;
#pragma unroll
            for (int e = 0; e < NE; ++e) if (e != e0 && lg[e] > v1) { v1 = lg[e]; e1 = e; }
            const float ex = __expf(v1 - v0), w0 = 1.0f / (1.0f + ex), w1 = ex / (1.0f + ex);
            if (lane == 0) {
                const unsigned p0 = __hip_atomic_fetch_add((unsigned*)(ctl + CW_CNT + 64 * e0), 1u, RLX_AGENT);
                const unsigned p1 = __hip_atomic_fetch_add((unsigned*)(ctl + CW_CNT + 64 * e1), 1u, RLX_AGENT);
                v4u ra; ra.x = (unsigned)e0; ra.y = (unsigned)e1; ra.z = p0; ra.w = p1; v4u rb; rb.x = __float_as_uint(w0); rb.y = __float_as_uint(w1); rb.z = 0u; rb.w = 0u;
                *(v4u*)(route + (size_t)m * 8) = ra; *(v4u*)(route + (size_t)m * 8 + 4) = rb; }
        }
        __syncthreads();
        if (BOTH(11)) GRID_BAR();
    }
    int eoff[NE + 1]; int ecnt[NE];
    if (hi > 12) {
        eoff[0] = 0;
#pragma unroll
        for (int e = 0; e < NE; ++e) { ecnt[e] = (int)__hip_atomic_load((unsigned*)(ctl + CW_CNT + 64 * e), RLX_AGENT); eoff[e + 1] = eoff[e] + ((ecnt[e] + 255) & ~255); }
    } else {
#pragma unroll
        for (int e = 0; e < NE; ++e) { ecnt[e] = 0; eoff[e] = 0; } eoff[NE] = 0;
    }
    const int nMt = eoff[NE] >> 8;
    LAS int* texp = (LAS int*)(lds + TEXP_OFF);
    if (IN(12)) REP(12) {
        for (int t = gw; t < M; t += NGW) {
            const v4u ra = *(const v4u*)(route + (size_t)t * 8); const v4u rb = *(const v4u*)(route + (size_t)t * 8 + 4);
            int o0 = 0, o1 = 0;
#pragma unroll
            for (int e = 0; e < NE; ++e) { if ((int)ra.x == e) o0 = eoff[e]; if ((int)ra.y == e) o1 = eoff[e]; }
            const int d0 = o0 + (int)ra.z, d1 = o1 + (int)ra.w;
            const GAS v4u* src = (const GAS v4u*)((unsigned char*)HB + (size_t)t * D) + lane; GAS v4u* q0 = (GAS v4u*)((unsigned char*)HS + (size_t)d0 * D) + lane; GAS v4u* q1 = (GAS v4u*)((unsigned char*)HS + (size_t)d1 * D) + lane;
#pragma unroll
            for (int j = 0; j < 2; ++j) { const v4u v = src[64 * j]; v4u vs; vs.x = v.z; vs.y = v.w; vs.z = v.x; vs.w = v.y;
                const bool sp = (lane & 4) != 0; q0[64 * j] = (sp && (d0 & 4)) ? vs : v; q1[64 * j] = (sp && (d1 & 4)) ? vs : v; }
            if (lane == 0) { roww[d0] = __uint_as_float(rb.x); roww[d1] = __uint_as_float(rb.y); }
        }
#pragma unroll
        for (int e = 0; e < NE; ++e) { const int npad = eoff[e + 1] - eoff[e] - ecnt[e];
            for (int i = gw; i < npad; i += NGW) { const int row = eoff[e] + ecnt[e] + i; GAS v4u* q0 = (GAS v4u*)((unsigned char*)HS + (size_t)row * D) + lane;
#pragma unroll
                for (int j = 0; j < 2; ++j) q0[64 * j] = (v4u){0u, 0u, 0u, 0u};
                if (lane == 0) roww[row] = 0.f; } }
        if (BOTH(12)) GRID_BAR();
    }
    if (hi > 13) {
        for (int mt = tid; mt < 144; mt += NWAVES * 64) { int e = 0;
#pragma unroll
            for (int k = 1; k < NE; ++k) if (mt * 256 >= eoff[k]) e = k;
            texp[mt] = e; }
        __syncthreads();
    }
    if (IN(13)) REP(13) {
        pg8::Gemm g{HS, Wegu_t, PMAX, 2 * FE, D / 2, D / 2}; pg8::GroupedOrder S; S.init(nMt, 2 * FE, G, bid, (const LAS int*)texp, WGM13);
        pg8::EpiSwiGLU<2> E{HE, FE, nullptr, 1.0f / (W6SCALE * A6SCALE)};
        RUN_GEMM_F6(pg8::EpiSwiGLU<2>, pg8::GroupedOrder, g, S, E);
        if (BOTH(13)) GRID_BAR();
    }
    const int nwg14 = nMt * (D / 256), L0_14 = (nwg14 / G) * G, R14 = nwg14 - L0_14;
    int ts14 = 1;
    if (R14 > 0) { if (14 * R14 <= G) ts14 = 14; else if (7 * R14 <= G) ts14 = 7; else if (4 * R14 <= G) ts14 = 4; else if (2 * R14 <= G) ts14 = 2; }
    float* PTL = (float*)(ws + WS_PTL);
    if (IN(14)) REP(14) {
        { pg8::Gemm g{HE, Wed_t, PMAX, D, FE / 2, FE / 2}; pg8::GroupedOrder S; S.init(nMt, D, G, bid, (const LAS int*)texp, WGM14); if (ts14 > 1) S.lim = L0_14;
          pg8::EpiRowScale E{YS, D, roww, 1.0f / (W6SCALE_D * H6SCALE)};
          RUN_GEMM_F6B(pg8::EpiRowScale, pg8::GroupedOrder, g, S, E); }
        if (ts14 > 1) { pg8::Gemm g{HE, Wed_t, PMAX, D, FE / 2, FE / 2 / ts14}; pg8::TailOrder S{nMt, D / 256, nwg14, bid, L0_14, R14 * ts14, ts14, FE / 2 / ts14, WGM14, (const LAS int*)texp};
          pg8::EpiPartial E{PTL};
          RUN_GEMM_F6B(pg8::EpiPartial, pg8::TailOrder, g, S, E); }
        if (BOTH(14)) GRID_BAR();
    }
    if (IN(15)) REP(15) {
        if (ts14 > 1) {
            for (int idx = gt; idx < R14 * 16384; idx += NGT) {
                const int q = idx >> 14, rem = idx & 16383, rowl = rem >> 6, c4 = (rem & 63) * 4; int pm, pn; pg8::map_unit(L0_14 + q, nMt, D / 256, nwg14, pm, pn, WGM14);
                const float* p = PTL + (size_t)q * ts14 * 65536 + rowl * 256 + c4; f32x4 a = *(const f32x4*)p;
                for (int ch = 1; ch < ts14; ++ch) a += *(const f32x4*)(p + (size_t)ch * 65536);
                const int row = pm * 256 + rowl; const float w = roww[row] * (1.0f / (W6SCALE_D * H6SCALE));
                v2u o; o.x = pk2(a.x * w, a.y * w); o.y = pk2(a.z * w, a.w * w); *(v2u*)(YS + (size_t)row * D + pn * 256 + c4) = o; }
        }
        if (BOTH(15)) GRID_BAR();
    }
    if (IN(16)) REP(16) {
        for (int t = gw; t < M; t += NGW) {
            const v4u ra = *(const v4u*)(route + (size_t)t * 8);
            int o0 = 0, o1 = 0;
#pragma unroll
            for (int e = 0; e < NE; ++e) { if ((int)ra.x == e) o0 = eoff[e]; if ((int)ra.y == e) o1 = eoff[e]; }
            const int d0 = o0 + (int)ra.z, d1 = o1 + (int)ra.w;
            const GAS v4u* y0 = (const GAS v4u*)(YS + (size_t)d0 * D) + lane; const GAS v4u* y1 = (const GAS v4u*)(YS + (size_t)d1 * D) + lane;
            GAS f32x4* xo = (GAS f32x4*)(xout + (size_t)t * D);
#pragma unroll
            for (int j = 0; j < 4; ++j) { const v4u a = y0[64 * j], b = y1[64 * j]; const int c = 2 * (lane + 64 * j);
                f32x4 p = xo[c], q = xo[c + 1];
                p.x += bflo(a.x) + bflo(b.x); p.y += bfhi(a.x) + bfhi(b.x); p.z += bflo(a.y) + bflo(b.y); p.w += bfhi(a.y) + bfhi(b.y);
                q.x += bflo(a.z) + bflo(b.z); q.y += bfhi(a.z) + bfhi(b.z); q.z += bflo(a.w) + bflo(b.w); q.w += bfhi(a.w) + bfhi(b.w);
                xo[c] = p; xo[c + 1] = q; }
        }
    }
#undef IN
#undef BOTH
}

extern "C" void kernel_launch(void* const* d_in, const int* in_sizes, int n_in, void* d_out, int out_size, void* d_ws, size_t ws_size, hipStream_t stream) {
    static int grid = 0;
    if (grid == 0) {
        if (n_in != 21 || in_sizes[0] != M * D || out_size != M * D || ws_size < WS_END) { fprintf(stderr, "kernel_launch: unexpected shapes (n_in %d, in0 %d, out %d, ws %zu < %zu)\n", n_in, n_in > 0 ? in_sizes[0] : -1, out_size, ws_size, (size_t)WS_END); grid = -1; return; }
        int dev = 0, cus = 0, per_cu = 0;
        if (hipGetDevice(&dev) != hipSuccess || hipDeviceGetAttribute(&cus, hipDeviceAttributeMultiprocessorCount, dev) != hipSuccess) { grid = -1; return; }
        if (hipFuncSetAttribute((const void*)mega_fwd, hipFuncAttributeMaxDynamicSharedMemorySize, LDS_BYTES) != hipSuccess) { fprintf(stderr, "kernel_launch: hipFuncSetAttribute failed\n"); grid = -1; return; }
        if (hipOccupancyMaxActiveBlocksPerMultiprocessor(&per_cu, (const void*)mega_fwd, NWAVES * 64, LDS_BYTES) != hipSuccess || per_cu < 1) fprintf(stderr, "kernel_launch: occupancy query reports %d\n", per_cu);
        (void)hipGetLastError();
        grid = cus;
    }
    if (grid < 0) return;
    if (hipMemsetAsync((char*)d_ws + WS_CTL, 0, CTL_ZERO_BYTES, stream) != hipSuccess) return;
    Args a{};
    for (int i = 0; i < 21; ++i) a.in[i] = (const float*)d_in[i];
    a.out = (float*)d_out; a.ws = (unsigned char*)d_ws;
    for (int li = 0; li < N_LAUNCHES; ++li) {
        a.ph_lo = (N_LAUNCHES == 1) ? 0 : li; a.ph_hi = (N_LAUNCHES == 1) ? N_PHASES : li + 1;
        hipLaunchKernelGGL(mega_fwd, dim3(grid), dim3(NWAVES * 64), LDS_BYTES, stream, a);
        const hipError_t le = hipPeekAtLastError();
        if (le != hipSuccess) { fprintf(stderr, "kernel_launch: launch %d failed: %s\n", li, hipGetErrorName(le)); break; }
    }
}
```
